# Optimizing an MI355X kernel written in HIP

```python
import jax, jax.numpy as jnp
from jax import lax
import numpy as np

D_MODEL = 1024
BATCH = 4
SEQ = 4096
DEPTH = 1

EPS = 1e-6
NEG = -1e30
CHUNK = 128
A_GROUPS = 4
A_WIDTH = D_MODEL
A_GROUP_W = A_WIDTH // A_GROUPS
B_PATTERNS = ((128, 1), (512, 4), (2048, 16))
B_NPAT = len(B_PATTERNS)
B_HEADS = 8
B_HEAD_DIM = 64
B_WIDTH = B_HEADS * B_HEAD_DIM
B_QKV = B_NPAT * 3 * B_WIDTH
N_IN = 3 * A_WIDTH + B_QKV + B_WIDTH + 2 * D_MODEL

kernel_name = "hybrid_gmlp_dilated_attn_gated_block"


def _rmsnorm(t, g):
    t32 = t.astype(jnp.float32)
    t32 = t32 * lax.rsqrt(jnp.mean(t32 * t32, axis=-1, keepdims=True) + EPS)
    return (t32 * g.astype(jnp.float32)).astype(t.dtype)


def _layernorm(t, g, b):
    t32 = t.astype(jnp.float32)
    mu = jnp.mean(t32, axis=-1, keepdims=True)
    var = jnp.mean(jnp.square(t32 - mu), axis=-1, keepdims=True)
    y = (t32 - mu) * lax.rsqrt(var + EPS) * g.astype(jnp.float32) + b.astype(jnp.float32)
    return y.astype(t.dtype)


def _gmlp_sgu(u, v, w_s, b_s, ln_g, ln_b):
    bsz, seq, _ = v.shape
    u = jax.nn.gelu(u)
    v = _layernorm(jax.nn.gelu(v), ln_g, ln_b)
    vc = v.reshape(bsz, seq // CHUNK, CHUNK, A_GROUPS, A_GROUP_W)
    mask = jnp.tril(jnp.ones((CHUNK, CHUNK), dtype=bool))
    w = jnp.where(mask[None], w_s, jnp.zeros_like(w_s))
    s = jnp.einsum('gij,bcjgh->bcigh', w, vc) + jnp.swapaxes(b_s, 0, 1)[None, None, :, :, None]
    return u * s.reshape(bsz, seq, A_WIDTH)


def _strided(t, d):
    bsz, seq = t.shape[:2]
    return jnp.swapaxes(t.reshape(bsz, seq // d, d, *t.shape[2:]), 1, 2)


def _unstrided(t, seq):
    bsz = t.shape[0]
    return jnp.swapaxes(t, 1, 2).reshape(bsz, seq, *t.shape[3:])


def _dilated_window(q, k, v, window, dilation):
    bsz, seq, nh, hd = q.shape
    n = window // dilation
    L = seq // dilation
    nb = -(-L // n)
    Lp = nb * n

    def blocks(t):
        t = _strided(t, dilation)
        t = jnp.pad(t, ((0, 0), (0, 0), (0, Lp - L), (0, 0), (0, 0)))
        return t.reshape(bsz, dilation, nb, n, nh, hd)

    def with_prev(t):
        prev = jnp.pad(t, ((0, 0), (0, 0), (1, 0), (0, 0), (0, 0), (0, 0)))[:, :, :-1]
        return jnp.concatenate([prev, t], axis=3)

    qb = blocks(q)
    kk = with_prev(blocks(k))
    vv = with_prev(blocks(v))
    s = jnp.einsum('bdcqhe,bdckhe->bdchqk', qb, kk).astype(jnp.float32) * (hd ** -0.5)
    qi = jnp.arange(n)[:, None]
    kj = jnp.arange(2 * n)[None, :]
    dist = qi + n - kj
    band = (dist >= 0) & (dist <= n)
    key_pos = jnp.arange(nb)[:, None] * n + jnp.arange(2 * n)[None, :] - n
    mask = band[None] & (key_pos >= 0)[:, None, :]
    s = jnp.where(mask[:, None], s, NEG)
    m = jnp.max(s, axis=-1, keepdims=True)
    e = jnp.exp(s - m)
    den = jnp.sum(e, axis=-1, keepdims=True)
    p = (e / den).astype(v.dtype)
    o = jnp.einsum('bdchqk,bdckhe->bdcqhe', p, vv)
    lse = jnp.swapaxes((m + jnp.log(den))[..., 0], 3, 4)
    o = o.reshape(bsz, dilation, Lp, nh, hd)[:, :, :L]
    lse = lse.reshape(bsz, dilation, Lp, nh)[:, :, :L]
    return _unstrided(o, seq), _unstrided(lse, seq)


def _dilated_mixture(qkv, qn_g, kn_g):
    outs, lses = [], []
    for p, (window, dilation) in enumerate(B_PATTERNS):
        q = _rmsnorm(qkv[:, :, p, 0], qn_g[p])
        k = _rmsnorm(qkv[:, :, p, 1], kn_g[p])
        o, lse = _dilated_window(q, k, qkv[:, :, p, 2], window, dilation)
        outs.append(o)
        lses.append(lse)
    wts = jax.nn.softmax(jnp.stack(lses, axis=0), axis=0)
    o = jnp.sum(wts[..., None].astype(qkv.dtype) * jnp.stack(outs, axis=0), axis=0)
    return o


def setup_inputs(seed: int = 0) -> dict:
    key = jax.random.key(seed)
    ks = jax.random.split(key, 12)
    f32 = jnp.float32
    x = jax.random.normal(ks[0], (BATCH, SEQ, D_MODEL), f32)
    norm_g = 1.0 + 0.02 * jax.random.normal(ks[1], (DEPTH, D_MODEL), f32)
    w_in = jax.random.normal(ks[2], (DEPTH, D_MODEL, N_IN), f32) * D_MODEL ** -0.5
    a_ws = jax.random.normal(ks[3], (DEPTH, A_GROUPS, CHUNK, CHUNK), f32) * CHUNK ** -0.5
    a_bs = 1.0 + 0.02 * jax.random.normal(ks[4], (DEPTH, A_GROUPS, CHUNK), f32)
    a_ln_g = 1.0 + 0.02 * jax.random.normal(ks[5], (DEPTH, A_WIDTH), f32)
    a_ln_b = 0.02 * jax.random.normal(ks[6], (DEPTH, A_WIDTH), f32)
    b_qn_g = 1.0 + 0.02 * jax.random.normal(ks[7], (DEPTH, B_NPAT, B_HEAD_DIM), f32)
    b_kn_g = 1.0 + 0.02 * jax.random.normal(ks[8], (DEPTH, B_NPAT, B_HEAD_DIM), f32)
    w_oa = jax.random.normal(ks[9], (DEPTH, A_WIDTH, D_MODEL), f32) * A_WIDTH ** -0.5
    w_ob = jax.random.normal(ks[10], (DEPTH, B_WIDTH, D_MODEL), f32) * B_WIDTH ** -0.5
    w_out = jax.random.normal(ks[11], (DEPTH, D_MODEL, D_MODEL), f32) * D_MODEL ** -0.5
    return {"x": x, "norm_g": norm_g, "w_in": w_in, "a_ws": a_ws, "a_bs": a_bs,
            "a_ln_g": a_ln_g, "a_ln_b": a_ln_b, "b_qn_g": b_qn_g, "b_kn_g": b_kn_g,
            "w_oa": w_oa, "w_ob": w_ob, "w_out": w_out}


def reference(x, norm_g, w_in, a_ws, a_bs, a_ln_g, a_ln_b, b_qn_g, b_kn_g, w_oa, w_ob, w_out):
    bsz, seq, _ = x.shape
    split_pts = np.cumsum([A_WIDTH, A_WIDTH, A_WIDTH, B_QKV, B_WIDTH, D_MODEL]).tolist()
    for l in range(DEPTH):
        h = _rmsnorm(x, norm_g[l])
        proj = jnp.einsum('bsd,dn->bsn', h, w_in[l])
        a_u, a_v, a_gate, b_qkv, b_gate, g_a, g_b = jnp.split(proj, split_pts, axis=-1)
        ya = _gmlp_sgu(a_u, a_v, a_ws[l], a_bs[l], a_ln_g[l], a_ln_b[l]) * jax.nn.silu(a_gate)
        ya = jnp.einsum('bsc,cd->bsd', ya, w_oa[l])
        qkv = b_qkv.reshape(bsz, seq, B_NPAT, 3, B_HEADS, B_HEAD_DIM)
        yb = _dilated_mixture(qkv, b_qn_g[l], b_kn_g[l]).reshape(bsz, seq, B_WIDTH)
        yb = jnp.einsum('bsc,cd->bsd', yb * jax.nn.silu(b_gate), w_ob[l])
        merged = jax.nn.sigmoid(g_a) * ya + jax.nn.sigmoid(g_b) * yb
        x = x + jnp.einsum('bsd,de->bse', merged, w_out[l])
    return x
```

```cpp
#include <hip/hip_runtime.h>
#include <cstdint>
#include <cstdio>

typedef unsigned short bf16_t;
typedef short bf16x8 __attribute__((ext_vector_type(8)));
typedef float f32x4 __attribute__((ext_vector_type(4)));
typedef unsigned u32x4 __attribute__((ext_vector_type(4)));

constexpr int BATCH = 4, SEQ = 4096, D = 1024, M = BATCH * SEQ;
constexpr int NIN = 10240, NA = 5120, NB = 5120, LDR = 5120;
constexpr int CH = 128, AG = 4, AGW = 256;
constexpr int NH = 8, HD = 64, BW = 512;
constexpr float EPS = 1e-6f;
constexpr float LOG2E = 1.4426950408889634f;
constexpr float QSCALE = 0.125f * LOG2E;

constexpr size_t MiB = 1u << 20;
constexpr size_t WS_CTL = 0;
constexpr size_t WS_WIN = 2 * MiB;
constexpr size_t WS_WOA = 22 * MiB;
constexpr size_t WS_WOB = 24 * MiB;
constexpr size_t WS_WOUT = 25 * MiB;
constexpr size_t WS_AWS = 27 * MiB;
constexpr size_t WS_DEN = 28 * MiB;
constexpr size_t WS_STATS = 29 * MiB;
constexpr size_t WS_XN = 32 * MiB;
constexpr size_t WS_YB = 64 * MiB;
constexpr size_t WS_R = 80 * MiB;
constexpr size_t WS_END = 240 * MiB;
constexpr int CONST_OFF = 1024;

__device__ __forceinline__ unsigned f2bf(float f) { unsigned u = __builtin_bit_cast(unsigned, f); return (u + 0x7fffu + ((u >> 16) & 1u)) >> 16; }
__device__ __forceinline__ unsigned pk2(float lo, float hi) { return f2bf(lo) | (f2bf(hi) << 16); }
__device__ __forceinline__ float bf2f(unsigned short h) { return __builtin_bit_cast(float, (unsigned)h << 16); }
__device__ __forceinline__ float sigmoid_f(float x) { return __builtin_amdgcn_rcpf(1.f + __builtin_amdgcn_exp2f(-x * LOG2E)); }
__device__ __forceinline__ float silu_f(float x) { return x * sigmoid_f(x); }
__device__ __forceinline__ float gelu_f(float x) { const float u = 0.7978845608028654f * (x + 0.044715f * x * x * x); return x * sigmoid_f(2.f * u); }
__device__ __forceinline__ float wave_sum(float v) {
#pragma unroll
    for (int o = 1; o < 64; o <<= 1) v += __shfl_xor(v, o);
    return v;
}
__device__ __forceinline__ float wave_max(float v) {
#pragma unroll
    for (int o = 1; o < 64; o <<= 1) v = fmaxf(v, __shfl_xor(v, o));
    return v;
}
__host__ __device__ __forceinline__ int win_orig_col(int np) { if (np < 5120) return 3072 + np; const int j = np - 5120; return j < 3072 ? j : 8192 + (j - 3072); }

__global__ void __launch_bounds__(256) k_rmsnorm(const float* x, const float* g, bf16_t* xn) {
    const int row = blockIdx.x * 4 + (threadIdx.x >> 6), lane = threadIdx.x & 63;
    const f32x4* xr = (const f32x4*)(x + (size_t)row * D) + lane;
    f32x4 v[4]; float s = 0.f;
#pragma unroll
    for (int j = 0; j < 4; ++j) { v[j] = xr[64 * j]; s += (v[j].x * v[j].x + v[j].y * v[j].y) + (v[j].z * v[j].z + v[j].w * v[j].w); }
    const float rstd = 1.f / sqrtf(wave_sum(s) * (1.f / D) + EPS);
    unsigned long long* o8 = (unsigned long long*)(xn + (size_t)row * D) + lane;
#pragma unroll
    for (int j = 0; j < 4; ++j) { const f32x4 gg = ((const f32x4*)g)[lane + 64 * j];
        o8[64 * j] = (unsigned long long)pk2(v[j].x * rstd * gg.x, v[j].y * rstd * gg.y) | ((unsigned long long)pk2(v[j].z * rstd * gg.z, v[j].w * rstd * gg.w) << 32); }
}
template <bool PERMUTE> __global__ void __launch_bounds__(256) k_transpose(const float* W, int K, int N, bf16_t* Wt, int rows) {
    __shared__ float tile[32][33];
    const int nblk = rows / 32, kb = blockIdx.x / nblk, nb = blockIdx.x % nblk;
    const int tx = threadIdx.x & 31, ty = threadIdx.x >> 5;
    for (int i = ty; i < 32; i += 8) { const int r = nb * 32 + tx; const int col = PERMUTE ? win_orig_col(r) : r; tile[i][tx] = W[(size_t)(kb * 32 + i) * N + col]; }
    __syncthreads();
    for (int i = ty; i < 32; i += 8) Wt[(size_t)(nb * 32 + i) * K + kb * 32 + tx] = (bf16_t)f2bf(tile[tx][i]);
}
__global__ void __launch_bounds__(256) k_misc(const float* a_ws, bf16_t* aws, const float* qn, const float* kn, float* ctl) {
    const int idx = blockIdx.x * 256 + threadIdx.x;
    if (idx < AG * CH * CH) { const int i = (idx / CH) % CH, j = idx % CH; aws[idx] = (bf16_t)f2bf(j <= i ? a_ws[idx] : 0.f); }
    if (blockIdx.x == 0 && threadIdx.x < 64) {
        float c = 0.f;
        for (int p = 0; p < 3; ++p) { float mq = 0.f, mk = 0.f;
            mq = wave_max(fabsf(qn[p * 64 + threadIdx.x])); mk = wave_max(fabsf(kn[p * 64 + threadIdx.x]));
            c = fmaxf(c, mq * mk); }
        if (threadIdx.x == 0) ctl[CONST_OFF] = c * 64.f * QSCALE * 1.001f;
    }
}

__device__ __forceinline__ void gemm_strip(const bf16_t* A, int lda, const bf16_t* Bt, int ldb, int K, int row0, int col0, int lane, f32x4 (&acc)[4]) {
    const int fr = lane & 15, fq = lane >> 4;
    const bf16_t* ap = A + (size_t)(row0 + fr) * lda + 8 * fq;
    const bf16_t* bp = Bt + (size_t)(col0 + fr) * ldb + 8 * fq;
    for (int k0 = 0; k0 < K; k0 += 32) {
        const bf16x8 a = *(const bf16x8*)(ap + k0);
#pragma unroll
        for (int n = 0; n < 4; ++n) { const bf16x8 b = *(const bf16x8*)(bp + (size_t)(16 * n) * ldb + k0); acc[n] = __builtin_amdgcn_mfma_f32_16x16x32_bf16(a, b, acc[n], 0, 0, 0); }
    }
}
struct GArgs { const bf16_t* xn; const bf16_t* win; bf16_t* R; float* stats; const float* qn; const float* kn; const bf16_t* woa; const bf16_t* wob; const bf16_t* wout; const bf16_t* yb; const float* x; float* out; };

template <int MODE> __global__ void __launch_bounds__(256) k_gemm(GArgs g) {
    const int lane = threadIdx.x & 63, fr = lane & 15, fq = lane >> 4;
    const int widx = blockIdx.x * 4 + (threadIdx.x >> 6);
    const int wm = widx % (M / 16), wn = widx / (M / 16);
    const int row0 = wm * 16, col0 = wn * 64;
    f32x4 acc[4];
#pragma unroll
    for (int n = 0; n < 4; ++n) acc[n] = (f32x4){0.f, 0.f, 0.f, 0.f};
    if (MODE == 0) {
        gemm_strip(g.xn, D, g.win, D, D, row0, col0, lane, acc);
        if (col0 < 4608) {
            const int seg = col0 / 512, p = seg / 3, which = seg % 3;
            if (which < 2) {
                const float* gg = (which == 0 ? g.qn : g.kn) + p * 64;
#pragma unroll
                for (int j = 0; j < 4; ++j) {
                    float ss = 0.f;
#pragma unroll
                    for (int n = 0; n < 4; ++n) ss += acc[n][j] * acc[n][j];
                    ss += __shfl_xor(ss, 1); ss += __shfl_xor(ss, 2); ss += __shfl_xor(ss, 4); ss += __shfl_xor(ss, 8);
                    const float rstd = 1.f / sqrtf(ss * (1.f / 64.f) + EPS) * (which == 0 ? QSCALE : 1.f);
#pragma unroll
                    for (int n = 0; n < 4; ++n) acc[n][j] = acc[n][j] * rstd * gg[16 * n + fr];
                }
            }
        } else {
#pragma unroll
            for (int n = 0; n < 4; ++n)
#pragma unroll
                for (int j = 0; j < 4; ++j) acc[n][j] = silu_f(acc[n][j]);
        }
#pragma unroll
        for (int n = 0; n < 4; ++n)
#pragma unroll
            for (int j = 0; j < 4; ++j) g.R[(size_t)(row0 + 4 * fq + j) * LDR + col0 + 16 * n + fr] = (bf16_t)f2bf(acc[n][j]);
    } else if (MODE == 1) {
        gemm_strip(g.xn, D, g.win + (size_t)NA * D, D, D, row0, col0, lane, acc);
        const int seg = col0 / 1024;
#pragma unroll
        for (int n = 0; n < 4; ++n)
#pragma unroll
            for (int j = 0; j < 4; ++j) { const float v = acc[n][j]; acc[n][j] = seg <= 1 ? gelu_f(v) : (seg == 2 ? silu_f(v) : sigmoid_f(v)); }
        if (seg == 1) {
#pragma unroll
            for (int j = 0; j < 4; ++j) {
                float s = 0.f, q = 0.f;
#pragma unroll
                for (int n = 0; n < 4; ++n) { s += acc[n][j]; q += acc[n][j] * acc[n][j]; }
                s += __shfl_xor(s, 1); s += __shfl_xor(s, 2); s += __shfl_xor(s, 4); s += __shfl_xor(s, 8);
                q += __shfl_xor(q, 1); q += __shfl_xor(q, 2); q += __shfl_xor(q, 4); q += __shfl_xor(q, 8);
                if (fr == 0) { float* st = g.stats + ((size_t)(row0 + 4 * fq + j) * 16 + (col0 - 1024) / 64) * 2; st[0] = s; st[1] = q; }
            }
        }
#pragma unroll
        for (int n = 0; n < 4; ++n)
#pragma unroll
            for (int j = 0; j < 4; ++j) g.R[(size_t)(row0 + 4 * fq + j) * LDR + col0 + 16 * n + fr] = (bf16_t)f2bf(acc[n][j]);
    } else if (MODE == 2) {
        gemm_strip(g.R, LDR, g.woa, D, D, row0, col0, lane, acc);
        f32x4 acb[4];
#pragma unroll
        for (int n = 0; n < 4; ++n) acb[n] = (f32x4){0.f, 0.f, 0.f, 0.f};
        gemm_strip(g.yb, BW, g.wob, BW, BW, row0, col0, lane, acb);
#pragma unroll
        for (int n = 0; n < 4; ++n)
#pragma unroll
            for (int j = 0; j < 4; ++j) { const size_t ro = (size_t)(row0 + 4 * fq + j) * LDR + col0 + 16 * n + fr;
                const float sa = bf2f(g.R[ro + 3072]), sb = bf2f(g.R[ro + 4096]);
                g.R[ro + 1024] = (bf16_t)f2bf(sa * acc[n][j] + sb * acb[n][j]); }
    } else {
        gemm_strip(g.R + 1024, LDR, g.wout, D, D, row0, col0, lane, acc);
#pragma unroll
        for (int n = 0; n < 4; ++n)
#pragma unroll
            for (int j = 0; j < 4; ++j) { const size_t o = (size_t)(row0 + 4 * fq + j) * D + col0 + 16 * n + fr; g.out[o] = g.x[o] + acc[n][j]; }
    }
}

template <bool COMBINE> __global__ void __launch_bounds__(256) k_attn(bf16_t* R, float* DEN, bf16_t* YB, const float* ctl) {
    __shared__ float qs[4][64];
    const int wv = threadIdx.x >> 6, lane = threadIdx.x & 63;
    const int widx = blockIdx.x * 4 + wv;
    const int h = widx % NH; int r = widx / NH; const int tok = r % M; const int p = COMBINE ? 0 : 1 + r / M;
    const int t = tok % SEQ; const int d = p == 0 ? 1 : (p == 1 ? 4 : 16);
    const float cneg = -ctl[CONST_OFF];
    bf16_t* qp = R + (size_t)tok * LDR + p * 1536 + h * 64;
    qs[wv][lane] = bf2f(qp[lane]);
    __syncthreads();
    float e[3];
#pragma unroll
    for (int ii = 0; ii < 3; ++ii) {
        const int i = lane + 64 * ii; e[ii] = 0.f;
        if (i <= 128 && t - d * i >= 0) {
            const bf16_t* kp = R + (size_t)(tok - d * i) * LDR + p * 1536 + 512 + h * 64;
            float s = 0.f;
#pragma unroll
            for (int c = 0; c < 8; ++c) { const u32x4 kv = *(const u32x4*)(kp + 8 * c);
#pragma unroll
                for (int w = 0; w < 4; ++w) { s += qs[wv][8 * c + 2 * w] * __builtin_bit_cast(float, kv[w] << 16) + qs[wv][8 * c + 2 * w + 1] * __builtin_bit_cast(float, kv[w] & 0xffff0000u); } }
            e[ii] = __builtin_amdgcn_exp2f(s + cneg);
        }
    }
    const float den = wave_sum(e[0] + e[1] + e[2]);
    float num = 0.f;
    for (int i = 0; i <= 128; ++i) {
        if (t - d * i < 0) break;
        const float ei = __shfl(i < 64 ? e[0] : (i < 128 ? e[1] : e[2]), i & 63);
        const float eb = bf2f((bf16_t)f2bf(ei));
        num += eb * bf2f(R[(size_t)(tok - d * i) * LDR + p * 1536 + 1024 + h * 64 + lane]);
    }
    if (!COMBINE) {
        qp[lane] = (bf16_t)f2bf(num);
        if (lane == 0) DEN[((size_t)(p - 1) * M + tok) * NH + h] = den;
    } else {
        const float n1 = bf2f(R[(size_t)tok * LDR + 1536 + h * 64 + lane]), n2 = bf2f(R[(size_t)tok * LDR + 3072 + h * 64 + lane]);
        const float dt = den + DEN[(size_t)tok * NH + h] + DEN[((size_t)M + tok) * NH + h];
        const float gb = bf2f(R[(size_t)tok * LDR + 4608 + h * 64 + lane]);
        YB[(size_t)tok * BW + h * 64 + lane] = (bf16_t)f2bf((num + n1 + n2) / dt * gb);
    }
}

__global__ void __launch_bounds__(128) k_sgu(bf16_t* R, const float* stats, const bf16_t* aws, const float* a_bs, const float* ln_g, const float* ln_b) {
    __shared__ float mean_s[CH], rstd_s[CH];
    __shared__ bf16_t vln[CH][128];
    const int half = blockIdx.x & 1, g = (blockIdx.x >> 1) % AG, ck = (blockIdx.x >> 1) / AG, tid = threadIdx.x;
    const int tok0 = ck * CH, ch = g * AGW + half * 128 + tid;
    { const float* st = stats + (size_t)(tok0 + tid) * 32; float s = 0.f, q = 0.f;
        for (int i = 0; i < 16; ++i) { s += st[2 * i]; q += st[2 * i + 1]; }
        const float mu = s * (1.f / 1024.f); const float var = fmaxf(q * (1.f / 1024.f) - mu * mu, 0.f);
        mean_s[tid] = mu; rstd_s[tid] = 1.f / sqrtf(var + EPS); }
    __syncthreads();
    const float lg = ln_g[ch], lb = ln_b[ch];
    for (int j = 0; j < CH; ++j) vln[j][tid] = (bf16_t)f2bf((bf2f(R[(size_t)(tok0 + j) * LDR + 1024 + ch]) - mean_s[j]) * rstd_s[j] * lg + lb);
    __syncthreads();
    for (int i = 0; i < CH; ++i) {
        const bf16_t* w = aws + ((size_t)g * CH + i) * CH; float s = 0.f;
        for (int j = 0; j <= i; ++j) s += bf2f(w[j]) * bf2f(vln[j][tid]);
        s += a_bs[g * CH + i];
        const size_t o = (size_t)(tok0 + i) * LDR + ch;
        R[o] = (bf16_t)f2bf(bf2f(R[o]) * s * bf2f(R[o + 2048]));
    }
}

extern "C" void kernel_launch(void* const* d_in, const int* in_sizes, int n_in, void* d_out, int out_size, void* d_ws, size_t ws_size, hipStream_t stream) {
    if (n_in != 12 || in_sizes[0] != M * D || out_size != M * D || ws_size < WS_END) { fprintf(stderr, "kernel_launch: unexpected shapes (n_in %d, in0 %d, out %d, ws %zu)\n", n_in, n_in > 0 ? in_sizes[0] : -1, out_size, ws_size); return; }
    const float* x = (const float*)d_in[0]; const float* norm_g = (const float*)d_in[1]; const float* w_in = (const float*)d_in[2];
    const float* a_ws = (const float*)d_in[3]; const float* a_bs = (const float*)d_in[4]; const float* a_ln_g = (const float*)d_in[5]; const float* a_ln_b = (const float*)d_in[6];
    const float* qn = (const float*)d_in[7]; const float* kn = (const float*)d_in[8]; const float* w_oa = (const float*)d_in[9]; const float* w_ob = (const float*)d_in[10]; const float* w_out = (const float*)d_in[11];
    unsigned char* ws = (unsigned char*)d_ws;
    float* ctl = (float*)(ws + WS_CTL);
    bf16_t* win = (bf16_t*)(ws + WS_WIN); bf16_t* woa = (bf16_t*)(ws + WS_WOA); bf16_t* wob = (bf16_t*)(ws + WS_WOB); bf16_t* wout = (bf16_t*)(ws + WS_WOUT);
    bf16_t* aws = (bf16_t*)(ws + WS_AWS); float* den = (float*)(ws + WS_DEN); float* stats = (float*)(ws + WS_STATS);
    bf16_t* xn = (bf16_t*)(ws + WS_XN); bf16_t* yb = (bf16_t*)(ws + WS_YB); bf16_t* R = (bf16_t*)(ws + WS_R);
    k_rmsnorm<<<M / 4, 256, 0, stream>>>(x, norm_g, xn);
    k_transpose<true><<<(D / 32) * (NIN / 32), 256, 0, stream>>>(w_in, D, NIN, win, NIN);
    k_transpose<false><<<(D / 32) * (D / 32), 256, 0, stream>>>(w_oa, D, D, woa, D);
    k_transpose<false><<<(BW / 32) * (D / 32), 256, 0, stream>>>(w_ob, BW, D, wob, D);
    k_transpose<false><<<(D / 32) * (D / 32), 256, 0, stream>>>(w_out, D, D, wout, D);
    k_misc<<<AG * CH * CH / 256, 256, 0, stream>>>(a_ws, aws, qn, kn, ctl);
    GArgs g{xn, win, R, stats, qn, kn, woa, wob, wout, yb, x, (float*)d_out};
    k_gemm<0><<<(M / 16) * (NA / 64) / 4, 256, 0, stream>>>(g);
    k_attn<false><<<2 * M * NH / 4, 256, 0, stream>>>(R, den, yb, ctl);
    k_attn<true><<<M * NH / 4, 256, 0, stream>>>(R, den, yb, ctl);
    k_gemm<1><<<(M / 16) * (NB / 64) / 4, 256, 0, stream>>>(g);
    k_sgu<<<(M / CH) * AG * 2, 128, 0, stream>>>(R, stats, aws, a_bs, a_ln_g, a_ln_b);
    k_gemm<2><<<(M / 16) * (D / 64) / 4, 256, 0, stream>>>(g);
    k_gemm<3><<<(M / 16) * (D / 64) / 4, 256, 0, stream>>>(g);
}
```

```cpp
#include <hip/hip_runtime.h>
#include <cstdint>
#include <cstdio>

typedef unsigned short bf16_t;
typedef short bf16x8 __attribute__((ext_vector_type(8)));
typedef float f32x4 __attribute__((ext_vector_type(4)));
typedef float f32x2 __attribute__((ext_vector_type(2)));
typedef unsigned u32x4 __attribute__((ext_vector_type(4)));

constexpr int BATCH = 4, SEQ = 4096, D = 1024, M = BATCH * SEQ;
constexpr int NIN = 10240, NA = 6144, NB = 4096, LDR = 5632;
constexpr int RC_V = 1024, RC_GATE = 2048, RC_U = 4096, RC_YB = 5120, RC_BGATE = 4608, KCAT = 1536;
__host__ __device__ __forceinline__ int sa_col(int j) { return j < 2 ? j * 256 : 3072 + (j - 2) * 256; }
__host__ __device__ __forceinline__ int sb_col(int j) { return j < 2 ? 512 + j * 256 : 3584 + (j - 2) * 256; }
constexpr int CH = 128, AG = 4, AGW = 256;
constexpr int NH = 8, HD = 64, BW = 512;
constexpr float EPS = 1e-6f;
constexpr float LOG2E = 1.4426950408889634f;
constexpr float QSCALE = 0.125f * LOG2E;

constexpr size_t MiB = 1u << 20;
constexpr size_t WS_CTL = 0, CTL_ZERO_BYTES = 1 * MiB;
constexpr float WA8_SCALE = 32.f;
constexpr size_t WS_WIN = 2 * MiB;
constexpr size_t WS_WCAT = 22 * MiB;
constexpr size_t WS_WOUT = 25 * MiB;
constexpr size_t WS_AWS = 27 * MiB;
constexpr size_t WS_DEN = 28 * MiB;
constexpr size_t WS_STATS = 29 * MiB;
constexpr size_t WS_XN = 32 * MiB;
constexpr size_t WS_R = 64 * MiB;
constexpr size_t WS_XN8 = 240 * MiB;
constexpr size_t WS_END = 256 * MiB;
constexpr int CW_BAR = 4096;
constexpr int CONST_OFF = 1024;

__device__ __forceinline__ unsigned f2bf(float f) { unsigned u = __builtin_bit_cast(unsigned, f); return (u + 0x7fffu + ((u >> 16) & 1u)) >> 16; }
typedef __bf16 bf16x2_t __attribute__((ext_vector_type(2)));
__device__ __forceinline__ unsigned pk2(float lo, float hi) { const f32x2 v = {lo, hi}; return __builtin_bit_cast(unsigned, __builtin_convertvector(v, bf16x2_t)); }
__device__ __forceinline__ float bf2f(unsigned short h) { return __builtin_bit_cast(float, (unsigned)h << 16); }
__device__ __forceinline__ float bflo(unsigned w) { return __builtin_bit_cast(float, w << 16); }
__device__ __forceinline__ float bfhi(unsigned w) { return __builtin_bit_cast(float, w & 0xffff0000u); }
__device__ __forceinline__ float sigmoid_f(float x) { return __builtin_amdgcn_rcpf(1.f + __builtin_amdgcn_exp2f(-x * LOG2E)); }
__device__ __forceinline__ float silu_f(float x) { return x * sigmoid_f(x); }
__device__ __forceinline__ float gelu_silu_f(float u, float g) { const float k = 0.7978845608028654f * (u + 0.044715f * u * u * u); const float ea = __builtin_amdgcn_exp2f(-2.f * LOG2E * k), eb = __builtin_amdgcn_exp2f(-LOG2E * g); return (u * g) * __builtin_amdgcn_rcpf((1.f + ea) * (1.f + eb)); }
__device__ __forceinline__ float gelu_f(float x) { const float u = 0.7978845608028654f * (x + 0.044715f * x * x * x); return x * sigmoid_f(2.f * u); }
__device__ __forceinline__ float wave_sum(float v) {
#pragma unroll
    for (int o = 1; o < 64; o <<= 1) v += __shfl_xor(v, o);
    return v;
}
__device__ __forceinline__ float wave_max(float v) {
#pragma unroll
    for (int o = 1; o < 64; o <<= 1) v = fmaxf(v, __shfl_xor(v, o));
    return v;
}
__host__ __device__ __forceinline__ int win_row_of_col(int c) { return c < 1024 ? 7168 + 2 * c : (c < 2048 ? c + 5120 : (c < 3072 ? 7168 + 2 * (c - 2048) + 32 : (c < 8192 ? c - 3072 : (c < 9216 ? c + 1024 : c - 4096)))); }

namespace pg8 {
#define PG8_LAS __attribute__((address_space(3)))
typedef unsigned short bf16_t;
typedef short bf16x8 __attribute__((ext_vector_type(8)));
typedef float f32x4 __attribute__((ext_vector_type(4)));
typedef unsigned u32x4 __attribute__((ext_vector_type(4)));
constexpr int BM = 256, BK = 64, HALF = 128, HTB = HALF * BK * 2  , STAGE_BYTES = 8 * HTB, NXCD = 8, WGM = 8;

__host__ __device__ __forceinline__ int lds_byte(int r, int c) { const int st = (r >> 4) * 2 + (c >> 5), rr = r & 15, cc = c & 31, ob = rr * 64 + cc * 2; return st * 1024 + (ob ^ (((ob >> 9) & 1) << 5)); }
__host__ __device__ __forceinline__ void stage_rc(int b, int& R, int& C) { const int st = b / 1024, sb = b % 1024, swz = sb ^ (((sb >> 9) & 1) << 5); R = (st >> 1) * 16 + swz / 64; C = (st & 1) * 32 + (swz % 64) / 2; }
__host__ __device__ __forceinline__ int perm32(int rho) { const int n = rho >> 4, i = rho & 15; return 8 * (i >> 2) + 4 * n + (i & 3); }

struct Unit { int pm, pn, sub; };
struct Gemm { const bf16_t* A; const bf16_t* Bt; int lda, ldb, K; };

struct StaticOrder {
    int nM, nN, nwg, G, c;
    __host__ __device__ void init(int M, int N, int G_, int c_) { nM = M / BM; nN = N / BM; nwg = nM * nN; G = G_; c = c_; }
    __host__ __device__ bool next(int i, Unit& u) const {
        const long L = (long)i * G + c; if (L >= nwg) return false;
        int wgid = (int)L; { const int q = nwg / NXCD, r = nwg % NXCD, xcd = wgid % NXCD, off = wgid / NXCD; wgid = (xcd < r ? xcd * (q + 1) : r * (q + 1) + (xcd - r) * q) + off; }
        const int nig = WGM * nN, gid = wgid / nig, fm = gid * WGM, gsz = (nM - fm) < WGM ? (nM - fm) : WGM;
        u.pm = fm + ((wgid % nig) % gsz); u.pn = (wgid % nig) / gsz; u.sub = 0; return true;
    }
    __device__ __forceinline__ void a_ready(const Unit&) const {}
    __device__ __forceinline__ void done(const Unit&) const {}
};
struct SplitOrder {
    StaticOrder base;
    __host__ __device__ void init(int M, int N, int G_, int c_) { base.init(M, N, G_, c_); }
    __host__ __device__ bool next(int i, Unit& u) const { if (!base.next(i >> 1, u)) return false; u.sub = i & 1; return true; }
    __device__ __forceinline__ void a_ready(const Unit&) const {}
    __device__ __forceinline__ void done(const Unit&) const {}
};

template <class Epi, class Sched, bool ALIGN_EPI, bool SP2, bool EXTACC>
__device__ __forceinline__ void gemm_phase_impl(PG8_LAS unsigned char* lds, const Gemm g, const Sched& S, const Epi& E, f32x4 (&acc)[2][2][4][2]) {
    int tid_ = threadIdx.x; asm volatile("" : "+v"(tid_));
    const int tid = tid_, wid = __builtin_amdgcn_readfirstlane(tid >> 6), lane = tid & 63, wr = wid >> 2, wc = wid & 3, fr = lane & 15, fq = lane >> 4;
    const int K = g.K, nt = K / BK;
    unsigned voffA[2], voffB[2];
#pragma unroll
    for (int i = 0; i < 2; ++i) { int R, C; stage_rc(tid * 16 + i * 8192, R, C); const int Rb = 64 * (R >> 5) + perm32(R & 31);
        voffA[i] = (unsigned)(R * g.lda + C) * 2u; voffB[i] = (unsigned)(Rb * g.ldb + C) * 2u; }
    const size_t kstep = (size_t)(BK * 2);
    const size_t hstepA = (size_t)HALF * g.lda * 2;
    const size_t hstepB = (size_t)32 * g.ldb * 2;
    const size_t tstepA = (size_t)BM * g.lda * 2, tstepB = (size_t)BM * g.ldb * 2;
    const unsigned ldsw = (unsigned)wid * 1024u;
    const int aoff = lds_byte(wr * 64 + fr, fq * 8), boff = lds_byte(wc * 32 + fr, fq * 8);
#define PG8_SA(b, h) (((b) * 2 + (h)) * HTB)
#define PG8_SB(b, h) ((4 + (b) * 2 + (h)) * HTB)
#define PG8_STAGE(bufoff, gbase, voff) do { _Pragma("unroll") for (int _i = 0; _i < 2; ++_i) \
        __builtin_amdgcn_global_load_lds((const unsigned*)((const char*)(gbase) + (voff)[_i]), (PG8_LAS unsigned*)(lds + (bufoff) + ldsw + _i * 8192), 16, 0, 0); } while (0)
typedef int pg8_v8i __attribute__((ext_vector_type(8)));
typedef int pg8_v4i __attribute__((ext_vector_type(4)));
#define PG8_LD32(p_) ({ const pg8_v4i l_ = *(const PG8_LAS pg8_v4i*)(p_), h_ = *(const PG8_LAS pg8_v4i*)((p_) + 1024); __builtin_shufflevector(l_, h_, 0, 1, 2, 3, 4, 5, 6, 7); })
#define PG8_LDA(dst, b, h) do { if constexpr (Epi::FP8) { _Pragma("unroll") for (int m = 0; m < 4; ++m) dst##8[m] = PG8_LD32(lds + PG8_SA(b, h) + aoff + m * 2048); } \
        else { _Pragma("unroll") for (int m = 0; m < 4; ++m) _Pragma("unroll") for (int k = 0; k < 2; ++k) dst[m][k] = *(const PG8_LAS bf16x8*)(lds + PG8_SA(b, h) + aoff + m * 2048 + k * 1024); } } while (0)
#define PG8_LDB(dst, b, h) do { if constexpr (Epi::FP8) { _Pragma("unroll") for (int n = 0; n < 2; ++n) dst##8[n] = PG8_LD32(lds + PG8_SB(b, h) + boff + n * 2048); } \
        else { _Pragma("unroll") for (int n = 0; n < 2; ++n) _Pragma("unroll") for (int k = 0; k < 2; ++k) dst[n][k] = *(const PG8_LAS bf16x8*)(lds + PG8_SB(b, h) + boff + n * 2048 + k * 1024); } } while (0)
#define PG8_MMA(ai, bj, At, Bt) do { __builtin_amdgcn_s_setprio(1); \
        if constexpr (Epi::FP8) { asm volatile("s_nop 4"); _Pragma("unroll") for (int m = 0; m < 4; ++m) _Pragma("unroll") for (int n = 0; n < 2; ++n) \
            asm volatile("v_mfma_scale_f32_16x16x128_f8f6f4 %0, %1, %2, %0, %3, %3 op_sel_hi:[0,0,0]" : "+v"(acc[ai][bj][m][n]) : "v"(Bt##8[n]), "v"(At##8[m]), "v"(0x7f7f7f7f)); \
            } \
        else { _Pragma("unroll") for (int m = 0; m < 4; ++m) _Pragma("unroll") for (int n = 0; n < 2; ++n) _Pragma("unroll") for (int k = 0; k < 2; ++k) \
            acc[ai][bj][m][n] = __builtin_amdgcn_mfma_f32_16x16x32_bf16(Bt[n][k], At[m][k], acc[ai][bj][m][n], 0, 0, 0); } \
        __builtin_amdgcn_s_setprio(0); } while (0)
#define PG8_WAIT_V(n) asm volatile("s_waitcnt vmcnt(" #n ")" ::: "memory")
#define PG8_WAIT_L(n) asm volatile("s_waitcnt lgkmcnt(" #n ")" ::: "memory")
#define PG8_BAR __builtin_amdgcn_s_barrier()
#define PG8_SCHED __builtin_amdgcn_sched_barrier(0)
    Unit cur, nxt; int ui = 0;
    if (!S.next(0, cur)) return;
    if constexpr (EXTACC) {}
    else if constexpr (Epi::PRELOAD) E.preload(acc, cur, wr, wc, fr, fq);
    else {
#pragma unroll
    for (int a = 0; a < 2; ++a)
#pragma unroll
        for (int b = 0; b < 2; ++b)
#pragma unroll
            for (int m = 0; m < 4; ++m)
#pragma unroll
                for (int n = 0; n < 2; ++n) acc[a][b][m][n] = (f32x4){0.f, 0.f, 0.f, 0.f};
    }
    bf16x8 At[4][2], B0[2][2], B1[2][2];
    pg8_v8i At8[4], B08[2], B18[2];
    const char* cA = (const char*)g.A + (size_t)cur.pm * tstepA + (Epi::SPLIT ? (size_t)cur.sub * 16 * kstep : 0); const char* cB = (const char*)g.Bt + (size_t)cur.pn * tstepB + (Epi::SPLIT ? (size_t)cur.sub * 16 * kstep : 0);
    S.a_ready(cur);
    if constexpr (SP2) {
        PG8_STAGE(PG8_SB(0, 0), cB, voffB); PG8_STAGE(PG8_SB(0, 1), cB + hstepB, voffB); PG8_STAGE(PG8_SA(0, 0), cA, voffA); PG8_STAGE(PG8_SA(0, 1), cA + hstepA, voffA);
        if (wr == 1) PG8_BAR;
        PG8_WAIT_V(2); PG8_BAR;
        PG8_STAGE(PG8_SB(1, 0), cB + kstep, voffB); PG8_STAGE(PG8_SA(1, 0), cA + kstep, voffA); PG8_STAGE(PG8_SB(1, 1), cB + hstepB + kstep, voffB);
        PG8_WAIT_V(6); PG8_BAR;
    } else {
        PG8_STAGE(PG8_SB(0, 0), cB, voffB); PG8_STAGE(PG8_SA(0, 0), cA, voffA); PG8_STAGE(PG8_SB(0, 1), cB + hstepB, voffB); PG8_STAGE(PG8_SA(0, 1), cA + hstepA, voffA);
        if (wr == 1) PG8_BAR;
        PG8_WAIT_V(4); PG8_BAR;
        PG8_STAGE(PG8_SB(1, 0), cB + kstep, voffB); PG8_STAGE(PG8_SA(1, 0), cA + kstep, voffA); PG8_STAGE(PG8_SB(1, 1), cB + hstepB + kstep, voffB);
        PG8_WAIT_V(6); PG8_BAR;
    }
    for (;;) {
        const bool has_next = S.next(ui + 1, nxt);
        const char* nA = has_next ? (const char*)g.A + (size_t)nxt.pm * tstepA + (Epi::SPLIT ? (size_t)nxt.sub * 16 * kstep : 0) : cA; const char* nB = has_next ? (const char*)g.Bt + (size_t)nxt.pn * tstepB + (Epi::SPLIT ? (size_t)nxt.sub * 16 * kstep : 0) : cB;
        const int ntu = Epi::SPLIT ? (cur.sub ? 8 : 16) : nt;
        for (int t = 0; t < ntu; t += 2) {
            const bool last = (t == ntu - 2);
            const char* a1 = cA + (size_t)(t + 1) * kstep;
            const char* a2 = last ? nA : cA + (size_t)(t + 2) * kstep; const char* b2 = last ? nB : cB + (size_t)(t + 2) * kstep;
            const char* a3 = a2 + kstep; const char* b3 = b2 + kstep;
            if (last && has_next) S.a_ready(nxt);
            if constexpr (SP2) {
            PG8_LDB(B0, 0, 0); PG8_LDB(B1, 0, 1); PG8_SCHED; PG8_LDA(At, 0, 0); PG8_STAGE(PG8_SA(1, 1), a1 + hstepA, voffA);
            PG8_WAIT_V(8); PG8_WAIT_L(0); PG8_BAR; PG8_MMA(0, 0, At, B0); PG8_MMA(0, 1, At, B1); PG8_BAR; PG8_SCHED;
            PG8_LDA(At, 0, 1); PG8_STAGE(PG8_SB(0, 0), b2, voffB); PG8_STAGE(PG8_SB(0, 1), b2 + hstepB, voffB); PG8_STAGE(PG8_SA(0, 0), a2, voffA);
            PG8_WAIT_V(8); PG8_WAIT_L(0); PG8_BAR; PG8_MMA(1, 0, At, B0); PG8_MMA(1, 1, At, B1); PG8_BAR; PG8_SCHED;
            PG8_LDB(B0, 1, 0); PG8_LDB(B1, 1, 1); PG8_SCHED; PG8_LDA(At, 1, 0); PG8_STAGE(PG8_SA(0, 1), a2 + hstepA, voffA);
            PG8_WAIT_V(8); PG8_WAIT_L(0); PG8_BAR; PG8_MMA(0, 0, At, B0); PG8_MMA(0, 1, At, B1); PG8_BAR; PG8_SCHED;
            PG8_LDA(At, 1, 1); PG8_STAGE(PG8_SB(1, 0), b3, voffB); PG8_STAGE(PG8_SB(1, 1), b3 + hstepB, voffB); PG8_STAGE(PG8_SA(1, 0), a3, voffA);
            PG8_WAIT_V(8); PG8_WAIT_L(0); PG8_BAR; PG8_MMA(1, 0, At, B0); PG8_MMA(1, 1, At, B1); PG8_BAR; PG8_SCHED;
            } else {
            PG8_LDB(B0, 0, 0); PG8_SCHED; PG8_LDA(At, 0, 0); PG8_STAGE(PG8_SA(1, 1), a1 + hstepA, voffA);
            PG8_WAIT_L(8); PG8_BAR; PG8_WAIT_L(0); PG8_MMA(0, 0, At, B0); PG8_BAR; PG8_SCHED;
            PG8_LDB(B1, 0, 1); PG8_STAGE(PG8_SB(0, 0), b2, voffB);
            PG8_BAR; PG8_WAIT_L(0); PG8_MMA(0, 1, At, B1); PG8_BAR;
            PG8_LDA(At, 0, 1); PG8_STAGE(PG8_SA(0, 0), a2, voffA);
            PG8_BAR; PG8_WAIT_L(0); PG8_MMA(1, 0, At, B0); PG8_BAR; PG8_SCHED;
            PG8_STAGE(PG8_SB(0, 1), b2 + hstepB, voffB);
            PG8_WAIT_V(6); PG8_BAR; PG8_MMA(1, 1, At, B1); PG8_BAR;
            PG8_LDB(B0, 1, 0); PG8_SCHED; PG8_LDA(At, 1, 0); PG8_STAGE(PG8_SA(0, 1), a2 + hstepA, voffA);
            PG8_WAIT_L(8); PG8_BAR; PG8_WAIT_L(0); PG8_MMA(0, 0, At, B0); PG8_BAR; PG8_SCHED;
            PG8_LDB(B1, 1, 1); PG8_STAGE(PG8_SB(1, 0), b3, voffB);
            PG8_BAR; PG8_WAIT_L(0); PG8_MMA(0, 1, At, B1); PG8_BAR;
            PG8_LDA(At, 1, 1); PG8_STAGE(PG8_SA(1, 0), a3, voffA);
            PG8_BAR; PG8_WAIT_L(0); PG8_MMA(1, 0, At, B0); PG8_BAR; PG8_SCHED;
            PG8_STAGE(PG8_SB(1, 1), b3 + hstepB, voffB);
            PG8_WAIT_V(6); PG8_BAR; PG8_MMA(1, 1, At, B1); PG8_BAR;
            }
        }
        if constexpr (ALIGN_EPI) { if (wr == 0) PG8_BAR; }
        if constexpr (Epi::FP8) asm volatile("s_nop 15\n\ts_nop 15");
        if constexpr (Epi::GATED) { if (ui == 0) E.gate(); }
        const bool carry = Epi::SPLIT && cur.sub == 0;
        if constexpr (Epi::SPLIT) { if (carry) E.mid(acc, cur, wr, wc, fr, fq); else E(acc, cur, wr, wc, fr, fq); } else { E(acc, cur, wr, wc, fr, fq); }
        S.done(cur);
        if (!has_next) break;
        if (!carry) {
#pragma unroll
        for (int a = 0; a < 2; ++a)
#pragma unroll
            for (int b = 0; b < 2; ++b)
#pragma unroll
                for (int m = 0; m < 4; ++m)
#pragma unroll
                    for (int n = 0; n < 2; ++n) acc[a][b][m][n] = (f32x4){0.f, 0.f, 0.f, 0.f};
        }
        cur = nxt; cA = nA; cB = nB; ++ui;
        if constexpr (ALIGN_EPI) { if (wr == 1) PG8_BAR; }
    }
    PG8_WAIT_V(0);
    if constexpr (!ALIGN_EPI) { if (wr == 0) PG8_BAR; }
    PG8_BAR;
#undef PG8_SA
#undef PG8_SB
#undef PG8_STAGE
#undef PG8_LDA
#undef PG8_LDB
#undef PG8_MMA
#undef PG8_WAIT_V
#undef PG8_WAIT_L
#undef PG8_BAR
#undef PG8_SCHED
}
template <class Epi, class Sched, bool ALIGN_EPI = false, bool SP2 = false>
__device__ __forceinline__ void gemm_phase(PG8_LAS unsigned char* lds, const Gemm g, const Sched& S, const Epi& E) {
    f32x4 acc[2][2][4][2];
    gemm_phase_impl<Epi, Sched, ALIGN_EPI, SP2, false>(lds, g, S, E, acc);
}
}

typedef const f32x4 (&AccRef)[2][2][4][2];
__device__ __forceinline__ u32x4 pack8(const f32x4 a, const f32x4 b) { u32x4 w; w.x = pk2(a[0], a[1]); w.y = pk2(a[2], a[3]); w.z = pk2(b[0], b[1]); w.w = pk2(b[2], b[3]); return w; }
__device__ __forceinline__ float sum_fq(float x) {
    const auto r = __builtin_amdgcn_permlane16_swap(__float_as_uint(x), __float_as_uint(x), false, false);
    const float s = __uint_as_float(r[0]) + __uint_as_float(r[1]);
    const auto q = __builtin_amdgcn_permlane32_swap(__float_as_uint(s), __float_as_uint(s), false, false);
    return __uint_as_float(q[0]) + __uint_as_float(q[1]);
}
__device__ __forceinline__ float sumsq4(const f32x4 a) { return (a[0] * a[0] + a[1] * a[1]) + (a[2] * a[2] + a[3] * a[3]); }
__device__ __forceinline__ float sum4(const f32x4 a) { return (a[0] + a[1]) + (a[2] + a[3]); }
template <class F> __device__ __forceinline__ f32x4 map4(const f32x4 a, F f) { return (f32x4){f(a[0]), f(a[1]), f(a[2]), f(a[3])}; }
__device__ __forceinline__ f32x2 lo2(const f32x4 a) { return __builtin_shufflevector(a, a, 0, 1); }
__device__ __forceinline__ f32x2 hi2(const f32x4 a) { return __builtin_shufflevector(a, a, 2, 3); }
__device__ __forceinline__ f32x2 exp2_2(const f32x2 a) { return (f32x2){__builtin_amdgcn_exp2f(a.x), __builtin_amdgcn_exp2f(a.y)}; }
__device__ __forceinline__ f32x2 rcp_2(const f32x2 a) { return (f32x2){__builtin_amdgcn_rcpf(a.x), __builtin_amdgcn_rcpf(a.y)}; }
__device__ __forceinline__ unsigned pk2v(const f32x2 v) { return __builtin_bit_cast(unsigned, __builtin_convertvector(v, bf16x2_t)); }
constexpr float GELU_A = -2.f * LOG2E * 0.7978845608028654f, GELU_B = GELU_A * 0.044715f;
__device__ __forceinline__ f32x2 gelu_2(const f32x2 u) { const f32x2 e = exp2_2(u * (u * u * GELU_B + GELU_A)); return u * rcp_2(e + 1.f); }
__device__ __forceinline__ f32x2 sigmoid_2(const f32x2 x, const float nsc) { return rcp_2(exp2_2(x * nsc) + 1.f); }
__device__ __forceinline__ f32x2 gelu_silu_2(const f32x2 u, const f32x2 g) { const f32x2 ea = exp2_2(u * (u * u * GELU_B + GELU_A)), eb = exp2_2(g * (-LOG2E)); return (u * g) * rcp_2((ea + 1.f) * (eb + 1.f)); }
__device__ __forceinline__ f32x4 cat2(const f32x2 a, const f32x2 b) { return __builtin_shufflevector(a, b, 0, 1, 2, 3); }

struct EpiA {
    static constexpr bool SPLIT = false, PRELOAD = false, FP8 = true, GATED = false;
    bf16_t* R; const __attribute__((address_space(3))) float* gl;
    __device__ __forceinline__ void operator()(AccRef acc, const pg8::Unit& u, int wr, int wc, int fr, int fq) const {
        const int pn = u.pn; int mode = pn >= 20 ? 3 : 2; const __attribute__((address_space(3))) float* gg = gl; float sc = 1.f;
        if (pn < 18) { const int seg = pn >> 1, p = seg / 3, which = seg - 3 * p; mode = which == 2 ? 0 : 1; gg = gl + (which == 0 ? 0 : 192) + p * 64; sc = which == 0 ? QSCALE * 8.f : 1.f; }
        const int kslot = (pn < 18 && ((pn >> 1) % 3) == 1) ? 2 : 0;
        f32x4 gv[2][2];
#pragma unroll
        for (int bj = 0; bj < 2; ++bj)
#pragma unroll
            for (int n = 0; n < 2; ++n) gv[bj][n] = *(const __attribute__((address_space(3))) f32x4*)(gg + 32 * bj + 8 * fq + 4 * n);
#pragma unroll
        for (int ai = 0; ai < 2; ++ai)
#pragma unroll
            for (int m = 0; m < 4; ++m) {
                const int row = u.pm * 256 + ai * 128 + wr * 64 + m * 16 + fr;
                bf16_t* rowp = R + (size_t)row * LDR + (pn >= 20 ? sb_col(pn - 20) : pn * 256) + wc * 64 + 8 * fq;
                f32x4 v[2][2];
#pragma unroll
                for (int bj = 0; bj < 2; ++bj)
#pragma unroll
                    for (int n = 0; n < 2; ++n) v[bj][n] = acc[ai][bj][m][n];
                if (mode == 3) {
#pragma unroll
                    for (int bj = 0; bj < 2; ++bj)
#pragma unroll
                        for (int n = 0; n < 2; ++n) v[bj][n] = cat2(sigmoid_2(lo2(v[bj][n]), -LOG2E / WA8_SCALE), sigmoid_2(hi2(v[bj][n]), -LOG2E / WA8_SCALE));
                }
                if (mode == 1) {
                    f32x4 s4 = v[0][0] * v[0][0]; s4 = v[0][1] * v[0][1] + s4; s4 = v[1][0] * v[1][0] + s4; s4 = v[1][1] * v[1][1] + s4;
                    float ss = (s4[0] + s4[1]) + (s4[2] + s4[3]);
                    ss = sum_fq(ss);
                    const float rs = sc / sqrtf(ss * (1.f / 64.f) + EPS * (WA8_SCALE * WA8_SCALE));
#pragma unroll
                    for (int bj = 0; bj < 2; ++bj)
#pragma unroll
                        for (int n = 0; n < 2; ++n) v[bj][n] = v[bj][n] * rs * gv[bj][n];
                } else if (mode == 2) {
#pragma unroll
                    for (int bj = 0; bj < 2; ++bj)
#pragma unroll
                        for (int n = 0; n < 2; ++n) { const f32x4 y = v[bj][n] * (1.f / WA8_SCALE); v[bj][n] = y * cat2(sigmoid_2(lo2(v[bj][n]), -LOG2E / WA8_SCALE), sigmoid_2(hi2(v[bj][n]), -LOG2E / WA8_SCALE)); }
                }
                if (mode == 0) {
#pragma unroll
                    for (int bj = 0; bj < 2; ++bj)
#pragma unroll
                        for (int n = 0; n < 2; ++n) v[bj][n] = v[bj][n] * (1.f / WA8_SCALE);
                }
                if (mode == 0) {
                    const int p = (pn >> 1) / 3, dl = p == 0 ? 0 : (p == 1 ? 2 : 4), t = row & (SEQ - 1), odd = (t >> dl) & 1;
                    unsigned char* bp = (unsigned char*)(R + (size_t)(row - (odd << dl)) * LDR + pn * 256 + wc * 64) + 64 * odd + 8 * fq;
#pragma unroll
                    for (int bj = 0; bj < 2; ++bj) {
                        int w0 = __builtin_amdgcn_cvt_pk_fp8_f32(v[bj][0][0], v[bj][0][1], 0, false); w0 = __builtin_amdgcn_cvt_pk_fp8_f32(v[bj][0][2], v[bj][0][3], w0, true);
                        int w1 = __builtin_amdgcn_cvt_pk_fp8_f32(v[bj][1][0], v[bj][1][1], 0, false); w1 = __builtin_amdgcn_cvt_pk_fp8_f32(v[bj][1][2], v[bj][1][3], w1, true);
                        typedef int i32x2 __attribute__((ext_vector_type(2)));
                        *(i32x2*)(bp + 32 * bj) = (i32x2){w0, w1};
                    }
                } else if (mode == 1) {
                    unsigned char* bp = (unsigned char*)(R + (size_t)row * LDR + (pn - kslot) * 256 + wc * 64) + 32 * kslot + 8 * fq;
#pragma unroll
                    for (int bj = 0; bj < 2; ++bj) {
                        int w0 = __builtin_amdgcn_cvt_pk_fp8_f32(v[bj][0][0], v[bj][0][1], 0, false); w0 = __builtin_amdgcn_cvt_pk_fp8_f32(v[bj][0][2], v[bj][0][3], w0, true);
                        int w1 = __builtin_amdgcn_cvt_pk_fp8_f32(v[bj][1][0], v[bj][1][1], 0, false); w1 = __builtin_amdgcn_cvt_pk_fp8_f32(v[bj][1][2], v[bj][1][3], w1, true);
                        typedef int i32x2 __attribute__((ext_vector_type(2)));
                        *(i32x2*)(bp + 32 * bj) = (i32x2){w0, w1};
                    }
                } else {
#pragma unroll
                for (int bj = 0; bj < 2; ++bj) *(u32x4*)(rowp + 32 * bj) = pack8(v[bj][0], v[bj][1]);
                }
            }
    }
};
struct EpiB {
    static constexpr bool SPLIT = false, PRELOAD = false, FP8 = false, GATED = true;
    bf16_t* R; float* stats;
    unsigned* topgen; volatile __attribute__((address_space(3))) unsigned* st;
    __device__ __forceinline__ void gate() const { const unsigned gen = st[2]; unsigned sp = 0u; while (__hip_atomic_load(topgen, __ATOMIC_RELAXED, __HIP_MEMORY_SCOPE_AGENT) == gen) { __builtin_amdgcn_s_sleep(1); if (++sp > (1u << 22)) break; } }
    __device__ __forceinline__ void operator()(AccRef acc, const pg8::Unit& u, int wr, int wc, int fr, int fq) const {
        const int pn = u.pn;
#pragma unroll
        for (int ai = 0; ai < 2; ++ai)
#pragma unroll
            for (int m = 0; m < 4; ++m) {
                const int row = u.pm * 256 + ai * 128 + wr * 64 + m * 16 + fr;
                if (pn >= 4 && pn < 12) {
                    const f32x4 u0 = acc[ai][0][m][0], u1 = acc[ai][0][m][1], g0 = acc[ai][1][m][0], g1 = acc[ai][1][m][1];
                    u32x4 w; w.x = pk2v(gelu_silu_2(lo2(u0), lo2(g0))); w.y = pk2v(gelu_silu_2(hi2(u0), hi2(g0))); w.z = pk2v(gelu_silu_2(lo2(u1), lo2(g1))); w.w = pk2v(gelu_silu_2(hi2(u1), hi2(g1)));
                    *(u32x4*)(R + (size_t)row * LDR + RC_U + (pn - 4) * 128 + wc * 32 + 8 * fq) = w;
                    continue;
                }
                const int colb = pn < 4 ? RC_V + pn * 256 : sa_col(pn - 12);
                bf16_t* rowp = R + (size_t)row * LDR + colb + wc * 64 + 8 * fq;
                f32x4 v[2][2];
#pragma unroll
                for (int bj = 0; bj < 2; ++bj)
#pragma unroll
                    for (int n = 0; n < 2; ++n) { const f32x4 a = acc[ai][bj][m][n]; v[bj][n] = pn < 4 ? cat2(gelu_2(lo2(a)), gelu_2(hi2(a))) : cat2(sigmoid_2(lo2(a), -LOG2E), sigmoid_2(hi2(a), -LOG2E)); }
                if (pn < 4) {
                    const f32x4 s4 = (v[0][0] + v[0][1]) + (v[1][0] + v[1][1]);
                    f32x4 q4 = v[0][0] * v[0][0]; q4 = v[0][1] * v[0][1] + q4; q4 = v[1][0] * v[1][0] + q4; q4 = v[1][1] * v[1][1] + q4;
                    float s = (s4[0] + s4[1]) + (s4[2] + s4[3]), q = (q4[0] + q4[1]) + (q4[2] + q4[3]);
                    s = sum_fq(s); q = sum_fq(q);
                    if (fq == 0) *(f32x2*)(stats + ((size_t)row * 16 + pn * 4 + wc) * 2) = (f32x2){s, q};
                }
#pragma unroll
                for (int bj = 0; bj < 2; ++bj) *(u32x4*)(rowp + 32 * bj) = pack8(v[bj][0], v[bj][1]);
            }
    }
};
struct EpiM {
    static constexpr bool SPLIT = true, PRELOAD = false, FP8 = false, GATED = false;
    bf16_t* R;
    __device__ __forceinline__ void mid(f32x4 (&acc)[2][2][4][2], const pg8::Unit& u, int wr, int wc, int fr, int fq) const {
#pragma unroll
        for (int ai = 0; ai < 2; ++ai)
#pragma unroll
            for (int m = 0; m < 4; ++m) {
                const int row = u.pm * 256 + ai * 128 + wr * 64 + m * 16 + fr;
                const bf16_t* sp = R + (size_t)row * LDR + wc * 64 + 8 * fq;
#pragma unroll
                for (int bj = 0; bj < 2; ++bj) {
                    const u32x4 a = *(const u32x4*)(sp + sa_col(u.pn) + 32 * bj), b = *(const u32x4*)(sp + sb_col(u.pn) + 32 * bj);
                    const f32x4 a0 = (f32x4){bflo(a.x), bfhi(a.x), bflo(a.y), bfhi(a.y)}, a1 = (f32x4){bflo(a.z), bfhi(a.z), bflo(a.w), bfhi(a.w)};
                    f32x4 r0, r1;
                    r0[0] = __builtin_amdgcn_rcpf(fmaxf(bflo(b.x), 1e-30f)); r0[1] = __builtin_amdgcn_rcpf(fmaxf(bfhi(b.x), 1e-30f)); r0[2] = __builtin_amdgcn_rcpf(fmaxf(bflo(b.y), 1e-30f)); r0[3] = __builtin_amdgcn_rcpf(fmaxf(bfhi(b.y), 1e-30f));
                    r1[0] = __builtin_amdgcn_rcpf(fmaxf(bflo(b.z), 1e-30f)); r1[1] = __builtin_amdgcn_rcpf(fmaxf(bfhi(b.z), 1e-30f)); r1[2] = __builtin_amdgcn_rcpf(fmaxf(bflo(b.w), 1e-30f)); r1[3] = __builtin_amdgcn_rcpf(fmaxf(bfhi(b.w), 1e-30f));
                    acc[ai][bj][m][0] = acc[ai][bj][m][0] * (a0 * r0); acc[ai][bj][m][1] = acc[ai][bj][m][1] * (a1 * r1);
                }
            }
    }
    __device__ __forceinline__ void operator()(AccRef acc, const pg8::Unit& u, int wr, int wc, int fr, int fq) const {
#pragma unroll
        for (int ai = 0; ai < 2; ++ai)
#pragma unroll
            for (int m = 0; m < 4; ++m) {
                const int row = u.pm * 256 + ai * 128 + wr * 64 + m * 16 + fr;
                bf16_t* rp = R + (size_t)row * LDR + u.pn * 256 + wc * 64 + 8 * fq;
                const bf16_t* sp = R + (size_t)row * LDR + sb_col(u.pn) + wc * 64 + 8 * fq;
#pragma unroll
                for (int bj = 0; bj < 2; ++bj) {
                    const u32x4 b = *(const u32x4*)(sp + 32 * bj);
                    f32x4 s0, s1;
                    s0[0] = fmaxf(bflo(b.x), 1e-30f); s0[1] = fmaxf(bfhi(b.x), 1e-30f); s0[2] = fmaxf(bflo(b.y), 1e-30f); s0[3] = fmaxf(bfhi(b.y), 1e-30f);
                    s1[0] = fmaxf(bflo(b.z), 1e-30f); s1[1] = fmaxf(bfhi(b.z), 1e-30f); s1[2] = fmaxf(bflo(b.w), 1e-30f); s1[3] = fmaxf(bfhi(b.w), 1e-30f);
                    *(u32x4*)(rp + RC_V + 32 * bj) = pack8(s0 * acc[ai][bj][m][0], s1 * acc[ai][bj][m][1]);
                }
            }
    }
};
struct EpiOut {
    static constexpr bool SPLIT = false, PRELOAD = true, FP8 = false, GATED = false;
    const float* x; float* out;
    __device__ __forceinline__ void preload(f32x4 (&acc)[2][2][4][2], const pg8::Unit& u, int wr, int wc, int fr, int fq) const {
#pragma unroll
        for (int ai = 0; ai < 2; ++ai)
#pragma unroll
            for (int m = 0; m < 4; ++m) {
                const int row = u.pm * 256 + ai * 128 + wr * 64 + m * 16 + fr;
                const size_t o = (size_t)row * D + u.pn * 256 + wc * 64 + 8 * fq;
#pragma unroll
                for (int bj = 0; bj < 2; ++bj) { acc[ai][bj][m][0] = *(const f32x4*)(x + o + 32 * bj); acc[ai][bj][m][1] = *(const f32x4*)(x + o + 32 * bj + 4); }
            }
    }
    __device__ __forceinline__ void operator()(AccRef acc, const pg8::Unit& u, int wr, int wc, int fr, int fq) const {
#pragma unroll
        for (int ai = 0; ai < 2; ++ai)
#pragma unroll
            for (int m = 0; m < 4; ++m) {
                const int row = u.pm * 256 + ai * 128 + wr * 64 + m * 16 + fr;
                const size_t o = (size_t)row * D + u.pn * 256 + wc * 64 + 8 * fq;
#pragma unroll
                for (int bj = 0; bj < 2; ++bj) { *(f32x4*)(out + o + 32 * bj) = acc[ai][bj][m][0]; *(f32x4*)(out + o + 32 * bj + 4) = acc[ai][bj][m][1]; }
            }
    }
};

#define GAS __attribute__((address_space(1)))
#define LAS __attribute__((address_space(3)))
typedef unsigned short bf16;
typedef unsigned v4u __attribute__((ext_vector_type(4)));
typedef float f32x4 __attribute__((ext_vector_type(4)));
typedef short bf16x8 __attribute__((ext_vector_type(8)));
typedef GAS unsigned gu32;
typedef GAS unsigned long long gu64;
#define RLX_AGENT __ATOMIC_RELAXED, __HIP_MEMORY_SCOPE_AGENT
#define LDS_WAIT() asm volatile("s_waitcnt lgkmcnt(0)" ::: "memory")
#define VM_WAIT() asm volatile("s_waitcnt vmcnt(0)" ::: "memory")
__device__ __forceinline__ unsigned long long rt() { return __builtin_amdgcn_s_memrealtime(); }

#define XB_TMO      128
#define XB_XCNT(j)  (256  + 64 * (j))
#define XB_XSUB(j)  (1280 + 64 * (j))
#define XB_XGEN(j)  (2304 + 64 * (j))
#define XB_TOP      3328
#define XB_TOPGEN   3392
#define XCD_BAR_WORDS 3456
#define XB_SPIN_CAP (1u << 18)

__device__ __forceinline__ unsigned xb_ld(unsigned* p)              { return __hip_atomic_load(p, __ATOMIC_RELAXED, __HIP_MEMORY_SCOPE_AGENT); }
__device__ __forceinline__ unsigned xb_add(unsigned* p, unsigned v) { return __hip_atomic_fetch_add(p, v, __ATOMIC_RELAXED, __HIP_MEMORY_SCOPE_AGENT); }
__device__ __forceinline__ unsigned xb_xcc_id() { return (unsigned)__builtin_amdgcn_s_getreg((3 << 11) | 20) & 0xFu; }
#define XB_SPIN(cond, bar) do { unsigned _sp = 0; while (cond) { __builtin_amdgcn_s_sleep(1); \
    if ((++_sp & 255u) == 0u) { if (xb_ld(&(bar)[XB_TMO])) break; if (_sp > XB_SPIN_CAP) { atomicAdd(&(bar)[XB_TMO], 1u); break; } } } } while (0)

struct XcdBarrier {
    unsigned* bar; unsigned x;
    volatile LAS unsigned* st;
};

__device__ __forceinline__ XcdBarrier xcd_barrier_post(unsigned* bar, volatile LAS unsigned* st) {
    XcdBarrier b; b.bar = bar; b.x = xb_xcc_id(); b.st = st;
    if (threadIdx.x == 0) (void)xb_add(&bar[XB_XCNT(b.x)], 1u);
    return b;
}
__device__ __forceinline__ void xcd_barrier_complete(unsigned* bar, unsigned x, unsigned& nloc, unsigned& nx) {
    const unsigned G = gridDim.x * gridDim.y * gridDim.z;
    unsigned sum, cnt, mine, sp = 0u;
    for (;;) {
        sum = 0u; cnt = 0u; mine = 0u;
#pragma unroll
        for (unsigned j = 0; j < 16; ++j) { const unsigned c = xb_ld(&bar[XB_XCNT(j)]); sum += c; cnt += (c > 0u) ? 1u : 0u; mine = (j == x) ? c : mine; }
        if (sum == G) break;
        __builtin_amdgcn_s_sleep(1);
        if ((++sp & 255u) == 0u) { if (xb_ld(&bar[XB_TMO])) break; if (sp > XB_SPIN_CAP) { atomicAdd(&bar[XB_TMO], 1u); break; } }
    }
    nloc = mine > 0u ? mine : 1u; nx = cnt > 0u ? cnt : 1u;
}

__device__ __forceinline__ void xcd_barrier_arrive() {
    asm volatile("s_waitcnt vmcnt(0)" ::: "memory");
    __syncthreads();
}
__device__ __forceinline__ void xcd_barrier_wait(const XcdBarrier& b) {
    if (threadIdx.x == 0) {
        unsigned* bar = b.bar;
        __builtin_amdgcn_s_waitcnt(0);
        unsigned nloc = b.st[0], nx = b.st[1];
        if (nloc == 0u) { xcd_barrier_complete(bar, b.x, nloc, nx); b.st[0] = nloc; b.st[1] = nx; }
        const unsigned old = xb_add(&bar[XB_XSUB(b.x)], 1u);
        const unsigned gen = old / nloc;
        if (old + 1u == (gen + 1u) * nloc) {
            __builtin_amdgcn_fence(__ATOMIC_RELEASE, "agent");
            asm volatile("s_waitcnt vmcnt(0)" ::: "memory");
            const unsigned og = xb_add(&bar[XB_TOP], 1u);
            const unsigned tg = og / nx;
            if (og + 1u == (tg + 1u) * nx) xb_add(&bar[XB_TOPGEN], 1u);
        }
        XB_SPIN(xb_ld(&bar[XB_TOPGEN]) == gen, bar);
        __builtin_amdgcn_fence(__ATOMIC_ACQUIRE, "agent");
        asm volatile("s_waitcnt vmcnt(0)" ::: "memory");
    }
    __syncthreads();
}
__device__ __forceinline__ void xcd_barrier(const XcdBarrier& b) { xcd_barrier_arrive(); xcd_barrier_wait(b); }
__device__ __forceinline__ void xcd_barrier_signal(const XcdBarrier& b) {
    if (threadIdx.x == 0) {
        unsigned* bar = b.bar;
        __builtin_amdgcn_s_waitcnt(0);
        unsigned nloc = b.st[0], nx = b.st[1];
        if (nloc == 0u) { xcd_barrier_complete(bar, b.x, nloc, nx); b.st[0] = nloc; b.st[1] = nx; }
        const unsigned old = xb_add(&bar[XB_XSUB(b.x)], 1u);
        const unsigned gen = old / nloc;
        if (old + 1u == (gen + 1u) * nloc) {
            __builtin_amdgcn_fence(__ATOMIC_RELEASE, "agent");
            asm volatile("s_waitcnt vmcnt(0)" ::: "memory");
            const unsigned og = xb_add(&bar[XB_TOP], 1u);
            const unsigned tg = og / nx;
            if (og + 1u == (tg + 1u) * nx) xb_add(&bar[XB_TOPGEN], 1u);
        }
        b.st[2] = gen;
    }
}
__device__ __forceinline__ void xcd_barrier_finish(const XcdBarrier& b) {
    if (threadIdx.x == 0) {
        unsigned* bar = b.bar; const unsigned gen = b.st[2];
        XB_SPIN(xb_ld(&bar[XB_TOPGEN]) == gen, bar);
        __builtin_amdgcn_fence(__ATOMIC_ACQUIRE, "agent");
        asm volatile("s_waitcnt vmcnt(0)" ::: "memory");
    }
    __syncthreads();
}

__device__ __forceinline__ void cl_barrier_wait(unsigned* ctlw, unsigned* bar, int pm, unsigned target, int slot = 0, int pm2 = -1) {
    if (threadIdx.x == 0) {
        __builtin_amdgcn_s_waitcnt(0);
        const unsigned* xt = ctlw + 3072; const int b0 = (pm >> 3) + 8 * (pm & 7);
        const unsigned x0 = xb_ld((unsigned*)xt + b0), x1 = xb_ld((unsigned*)xt + b0 + 64), x2 = xb_ld((unsigned*)xt + b0 + 128), x3 = xb_ld((unsigned*)xt + b0 + 192);
        if (!(x0 == x1 && x1 == x2 && x2 == x3 && x0 != 0u)) { __builtin_amdgcn_fence(__ATOMIC_RELEASE, "agent"); asm volatile("s_waitcnt vmcnt(0)" ::: "memory"); }
        unsigned* cw = ctlw + 2048 + 16 * pm + slot;
        (void)xb_add(cw, 1u);
        XB_SPIN(xb_ld(cw) < target, bar);
        if (pm2 >= 0) { unsigned* cw2 = ctlw + 2048 + 16 * pm2 + slot; XB_SPIN(xb_ld(cw2) < target, bar); }
        __builtin_amdgcn_fence(__ATOMIC_ACQUIRE, "agent");
        asm volatile("s_waitcnt vmcnt(0)" ::: "memory");
    }
    __syncthreads();
}

typedef short s16x4 __attribute__((ext_vector_type(4)));
typedef short v4i16_t __attribute__((ext_vector_type(4)));
typedef float f32x16 __attribute__((ext_vector_type(16)));
__device__ __forceinline__ s16x4 vtr(const LAS unsigned char* p) { return __builtin_bit_cast(s16x4, __builtin_amdgcn_ds_read_tr16_b64_v4i16((LAS v4i16_t*)p)); }
__device__ __forceinline__ int crow(int r, int hi) { return (r & 3) + 8 * (r >> 2) + 4 * hi; }
__device__ __forceinline__ bf16x8 pack8s(const f32x16& s, int o) { u32x4 w; w.x = pk2(s[o], s[o + 1]); w.y = pk2(s[o + 2], s[o + 3]); w.z = pk2(s[o + 4], s[o + 5]); w.w = pk2(s[o + 6], s[o + 7]); return __builtin_bit_cast(bf16x8, w); }
constexpr int AT_KP = 72;
constexpr int AT_K_OFF = 0, AT_V_OFF = 384 * AT_KP, AT_VH = 384 * 64;
constexpr int AT_SP = 68, AT_SW = 32 * AT_SP * 4 + 128;

struct AttnGeom { bf16_t* base; int d, res, i0, b, h, p; };
__device__ __forceinline__ AttnGeom attn_geom(int p, int idx, bf16_t* R) {
    AttnGeom g; g.p = p; g.d = p == 0 ? 1 : (p == 1 ? 4 : 16); const int nblk = 16 / g.d;
    const int bh = idx >> 4, rem = idx & 15, blk = rem % nblk; g.res = rem / nblk; g.b = bh >> 3; g.h = bh & 7; g.i0 = blk * 256;
    g.base = R + (size_t)g.b * SEQ * LDR + p * 1536 + g.h * 64;
    return g;
}
typedef long fp8x8;
__device__ __forceinline__ void attn_load(const AttnGeom& g, int tid, u32x4 (&kr)[3], u32x4 (&vr)[3], fp8x8 (&qr)[4]) {
    const int lane = tid & 63, wave = tid >> 6, r32 = lane & 31, hi = lane >> 5;
#pragma unroll
    for (int k = 0; k < 3; ++k) {
        const int c = tid + 512 * k, rho = c >> 2, ch = c & 3, pos = g.i0 - 128 + rho;
        vr[k] = (u32x4){0u, 0u, 0u, 0u};
        if (pos >= 0) vr[k] = *(const u32x4*)((const unsigned char*)(g.base + (size_t)((pos & ~1) * g.d + g.res) * LDR + 1024) + 64 * (pos & 1) + ch * 16);
    }
#pragma unroll
    for (int k = 0; k < 3; ++k) {
        const int c = tid + 512 * k, rho = c >> 2, ch = c & 3, pos = g.i0 - 128 + rho;
        kr[k] = (u32x4){0u, 0u, 0u, 0u};
        if (pos >= 0) kr[k] = *(const u32x4*)((const unsigned char*)(g.base + (size_t)(pos * g.d + g.res) * LDR) + 64 + ch * 16);
    }
    const unsigned char* qrow = (const unsigned char*)(g.base + (size_t)((g.i0 + 32 * wave + r32) * g.d + g.res) * LDR);
#pragma unroll
    for (int d0 = 0; d0 < 4; ++d0) qr[d0] = *(const fp8x8*)(qrow + 16 * d0 + 8 * hi);
}
__device__ __forceinline__ void attn_stage(const u32x4 (&kr)[3], const u32x4 (&vr)[3], LAS unsigned char* lds, int tid) {
    typedef unsigned u32x2 __attribute__((ext_vector_type(2)));
#pragma unroll
    for (int k = 0; k < 3; ++k) {
        const int c = tid + 512 * k, rho = c >> 2, ch = c & 3;
        *(LAS u32x2*)(lds + AT_K_OFF + rho * AT_KP + ch * 16) = (u32x2){kr[k].x, kr[k].y};
        *(LAS u32x2*)(lds + AT_K_OFF + rho * AT_KP + ch * 16 + 8) = (u32x2){kr[k].z, kr[k].w};
    }
#pragma unroll
    for (int k = 0; k < 3; ++k) {
        const int c = tid + 512 * k, rho = c >> 2, ch = c & 3;
        const u32x4 w = vr[k];
        u32x4 lo, hi2;
        lo.x = pk2(__builtin_amdgcn_cvt_f32_fp8(w.x, 0), __builtin_amdgcn_cvt_f32_fp8(w.x, 1)); lo.y = pk2(__builtin_amdgcn_cvt_f32_fp8(w.x, 2), __builtin_amdgcn_cvt_f32_fp8(w.x, 3));
        lo.z = pk2(__builtin_amdgcn_cvt_f32_fp8(w.y, 0), __builtin_amdgcn_cvt_f32_fp8(w.y, 1)); lo.w = pk2(__builtin_amdgcn_cvt_f32_fp8(w.y, 2), __builtin_amdgcn_cvt_f32_fp8(w.y, 3));
        hi2.x = pk2(__builtin_amdgcn_cvt_f32_fp8(w.z, 0), __builtin_amdgcn_cvt_f32_fp8(w.z, 1)); hi2.y = pk2(__builtin_amdgcn_cvt_f32_fp8(w.z, 2), __builtin_amdgcn_cvt_f32_fp8(w.z, 3));
        hi2.z = pk2(__builtin_amdgcn_cvt_f32_fp8(w.w, 0), __builtin_amdgcn_cvt_f32_fp8(w.w, 1)); hi2.w = pk2(__builtin_amdgcn_cvt_f32_fp8(w.w, 2), __builtin_amdgcn_cvt_f32_fp8(w.w, 3));
        LAS unsigned char* dst = lds + AT_V_OFF + (ch >> 1) * AT_VH + rho * 64 + (ch & 1) * 32;
        *(LAS u32x4*)dst = lo; *(LAS u32x4*)(dst + 16) = hi2;
    }
}
template <bool COMBINE> __device__ __forceinline__ void attn_compute(const AttnGeom& g, const fp8x8 (&qr)[4], bf16_t* R, float* DEN, float cneg, LAS unsigned char* lds, int tid) {
    const int lane = tid & 63, wave = __builtin_amdgcn_readfirstlane(tid >> 6), r32 = lane & 31, hi = lane >> 5;
    const int i0 = g.i0, d = g.d, res = g.res, b = g.b, h = g.h, p = g.p; bf16_t* base = g.base;
    f32x16 o0, o1, cinit; float den = 0.f;
#pragma unroll
    for (int r = 0; r < 16; ++r) { o0[r] = 0.f; o1[r] = 0.f; cinit[r] = cneg * 8.f; }
    const int q4 = (lane & 15) >> 2, pp = lane & 3, cb = (lane >> 4) & 1;
    typedef unsigned u32x2_t __attribute__((ext_vector_type(2)));
    u32x2_t pn1[4], pn2[4]; u32x4 pgb[4]; float pd1[4], pd2[4];
    if (COMBINE) {
#pragma unroll
        for (int i = 0; i < 4; ++i) {
            const int row = i * 8 + (lane >> 3), c = lane & 7;
            const size_t gt = (size_t)b * SEQ + (i0 + 32 * wave + row) * d + res;
            const bf16_t* rp = R + gt * LDR + h * 64 + c * 8;
            const unsigned char* np = (const unsigned char*)(R + gt * LDR + 1536 + 512 + h * 64) + c * 8;
            pn1[i] = *(const u32x2_t*)np; pn2[i] = *(const u32x2_t*)(np + 64); pgb[i] = *(const u32x4*)(rp + RC_BGATE);
            pd1[i] = DEN[gt * NH + h]; pd2[i] = DEN[((size_t)M + gt) * NH + h];
        }
    }
#define ATT_VALID(kk) (!(i0 == 0 && wave + (kk) < 4))
#define ATT_QK(kk, S) do { if (ATT_VALID(kk)) { \
        const LAS unsigned char* kp = lds + AT_K_OFF + (32 * (wave + (kk)) + r32) * AT_KP + 8 * hi; \
        const fp8x8 k0_ = *(const LAS fp8x8*)(kp), k1_ = *(const LAS fp8x8*)(kp + 16), k2_ = *(const LAS fp8x8*)(kp + 32), k3_ = *(const LAS fp8x8*)(kp + 48); \
        S = __builtin_amdgcn_mfma_f32_32x32x16_fp8_fp8(k0_, qr[0], cinit, 0, 0, 0); S = __builtin_amdgcn_mfma_f32_32x32x16_fp8_fp8(k1_, qr[1], S, 0, 0, 0); \
        S = __builtin_amdgcn_mfma_f32_32x32x16_fp8_fp8(k2_, qr[2], S, 0, 0, 0); S = __builtin_amdgcn_mfma_f32_32x32x16_fp8_fp8(k3_, qr[3], S, 0, 0, 0); } } while (0)
#define ATT_PV(kk, S) do { if (ATT_VALID(kk)) { \
        const LAS unsigned char* vp = lds + AT_V_OFF + (32 * (wave + (kk)) + 4 * hi + q4) * 64 + cb * 32 + pp * 8; \
        const s16x4 a0_ = vtr(vp), a1_ = vtr(vp + 512), b0_ = vtr(vp + AT_VH), b1_ = vtr(vp + AT_VH + 512); \
        const s16x4 a2_ = vtr(vp + 1024), a3_ = vtr(vp + 1536), b2_ = vtr(vp + AT_VH + 1024), b3_ = vtr(vp + AT_VH + 1536); \
        _Pragma("unroll") for (int r = 0; r < 16; ++r) { \
            float e = __builtin_amdgcn_exp2f(S[r] * 0.125f); \
            if ((kk) == 0) e = (crow(r, hi) >= r32) ? e : 0.f;              \
            if ((kk) == 4) e = (crow(r, hi) <= r32) ? e : 0.f;              \
            S[r] = e; den += e; } \
        const bf16x8 pa0 = pack8s(S, 0), pa1 = pack8s(S, 8); \
        o0 = __builtin_amdgcn_mfma_f32_32x32x16_bf16(pa0, (bf16x8){a0_[0], a0_[1], a0_[2], a0_[3], a1_[0], a1_[1], a1_[2], a1_[3]}, o0, 0, 0, 0); \
        o1 = __builtin_amdgcn_mfma_f32_32x32x16_bf16(pa0, (bf16x8){b0_[0], b0_[1], b0_[2], b0_[3], b1_[0], b1_[1], b1_[2], b1_[3]}, o1, 0, 0, 0); \
        o0 = __builtin_amdgcn_mfma_f32_32x32x16_bf16(pa1, (bf16x8){a2_[0], a2_[1], a2_[2], a2_[3], a3_[0], a3_[1], a3_[2], a3_[3]}, o0, 0, 0, 0); \
        o1 = __builtin_amdgcn_mfma_f32_32x32x16_bf16(pa1, (bf16x8){b2_[0], b2_[1], b2_[2], b2_[3], b3_[0], b3_[1], b3_[2], b3_[3]}, o1, 0, 0, 0); } } while (0)
    {
        f32x16 sA = cinit, sB = cinit;
        ATT_QK(0, sA); ATT_QK(1, sB);
        ATT_PV(0, sA); ATT_QK(2, sA);
        ATT_PV(1, sB); ATT_QK(3, sB);
        ATT_PV(2, sA); ATT_QK(4, sA);
        ATT_PV(3, sB);
        ATT_PV(4, sA);
    }
#undef ATT_VALID
#undef ATT_QK
#undef ATT_PV
    den += __shfl_xor(den, 32);
    __syncthreads();
    LAS float* stg = (LAS float*)(lds + wave * AT_SW); LAS float* dstg = stg + 32 * AT_SP;
#pragma unroll
    for (int r = 0; r < 16; ++r) { const int q = crow(r, hi); stg[q * AT_SP + r32] = o0[r]; stg[q * AT_SP + 32 + r32] = o1[r]; }
    if (hi == 0) dstg[r32] = den;
    LDS_WAIT(); asm volatile("" ::: "memory");
#pragma unroll
    for (int i = 0; i < 4; ++i) {
        const int row = i * 8 + (lane >> 3), c = lane & 7;
        const f32x4 a0 = *(const LAS f32x4*)(stg + row * AT_SP + c * 8), a1 = *(const LAS f32x4*)(stg + row * AT_SP + c * 8 + 4);
        const int tok = (i0 + 32 * wave + row) * d + res;
        const float dn = dstg[row];
        if (!COMBINE) {
            {
                const float rd = 1.f / dn; const f32x4 n0 = a0 * rd, n1 = a1 * rd;
                int w0 = __builtin_amdgcn_cvt_pk_fp8_f32(n0[0], n0[1], 0, false); w0 = __builtin_amdgcn_cvt_pk_fp8_f32(n0[2], n0[3], w0, true);
                int w1 = __builtin_amdgcn_cvt_pk_fp8_f32(n1[0], n1[1], 0, false); w1 = __builtin_amdgcn_cvt_pk_fp8_f32(n1[2], n1[3], w1, true);
                typedef int i32x2 __attribute__((ext_vector_type(2)));
                *(i32x2*)((unsigned char*)(R + ((size_t)b * SEQ + tok) * LDR + 1536 + 512 + h * 64) + 64 * (p - 1) + c * 8) = (i32x2){w0, w1};
            }
            if (c == 0) DEN[((size_t)(p - 1) * M + (size_t)b * SEQ + tok) * NH + h] = dn;
        } else {
            bf16_t* rp = R + ((size_t)b * SEQ + tok) * LDR + h * 64 + c * 8;
            const u32x2_t n1 = pn1[i], n2 = pn2[i]; const u32x4 gb = pgb[i];
            const float d1 = pd1[i], d2 = pd2[i], inv = 1.f / (dn + d1 + d2);
#define O8(w, k) __builtin_amdgcn_cvt_f32_fp8((int)(w), (k))
            f32x4 y0, y1;
            y0[0] = (a0[0] + d1 * O8(n1.x, 0) + d2 * O8(n2.x, 0)) * inv * bflo(gb.x); y0[1] = (a0[1] + d1 * O8(n1.x, 1) + d2 * O8(n2.x, 1)) * inv * bfhi(gb.x);
            y0[2] = (a0[2] + d1 * O8(n1.x, 2) + d2 * O8(n2.x, 2)) * inv * bflo(gb.y); y0[3] = (a0[3] + d1 * O8(n1.x, 3) + d2 * O8(n2.x, 3)) * inv * bfhi(gb.y);
            y1[0] = (a1[0] + d1 * O8(n1.y, 0) + d2 * O8(n2.y, 0)) * inv * bflo(gb.z); y1[1] = (a1[1] + d1 * O8(n1.y, 1) + d2 * O8(n2.y, 1)) * inv * bfhi(gb.z);
            y1[2] = (a1[2] + d1 * O8(n1.y, 2) + d2 * O8(n2.y, 2)) * inv * bflo(gb.w); y1[3] = (a1[3] + d1 * O8(n1.y, 3) + d2 * O8(n2.y, 3)) * inv * bfhi(gb.w);
#undef O8
            *(u32x4*)(rp + RC_YB) = pack8(y0, y1);
        }
    }
    __syncthreads();
}
template <bool COMBINE> __device__ __forceinline__ void attn_phase(int first, int stride, int n, bf16_t* R, float* DEN, float cneg, LAS unsigned char* lds, int tid, unsigned* gate_tg = nullptr, volatile LAS unsigned* gate_st = nullptr) {
    int i = first; if (i >= n) return;
    u32x4 kr[3], vr[3]; fp8x8 qn[4], qr[4];
    AttnGeom g = COMBINE ? attn_geom(0, i, R) : attn_geom(1 + (i >> 9), i & 511, R);
    attn_load(g, tid, kr, vr, qn);
    for (;;) {
        attn_stage(kr, vr, lds, tid);
#pragma unroll
        for (int d0 = 0; d0 < 4; ++d0) qr[d0] = qn[d0];
        __syncthreads();
        if (COMBINE && gate_tg != nullptr && i == first) {
            if (tid == 0) {
                const unsigned gen = gate_st[2]; unsigned sp = 0u;
                while (__hip_atomic_load(gate_tg, __ATOMIC_RELAXED, __HIP_MEMORY_SCOPE_AGENT) == gen) { __builtin_amdgcn_s_sleep(1); if (++sp > (1u << 22)) break; }
                __builtin_amdgcn_fence(__ATOMIC_ACQUIRE, "agent");
                asm volatile("s_waitcnt vmcnt(0)" ::: "memory");
            }
            __syncthreads();
        }
        const int inext = i + stride; const bool has = inext < n; AttnGeom gn = g;
        if (has) { gn = COMBINE ? attn_geom(0, inext, R) : attn_geom(1 + (inext >> 9), inext & 511, R); attn_load(gn, tid, kr, vr, qn); }
        attn_compute<COMBINE>(g, qr, R, DEN, cneg, lds, tid);
        if (!has) break;
        g = gn; i = inext;
    }
}

constexpr int SG_MS_OFF = 0, SG_V_OFF = 1024;
__device__ __forceinline__ void sgu_unit(int item, bf16_t* R, const float* stats, const bf16_t* aws, const float* a_bs, const float* ln_g, const float* ln_b, LAS unsigned char* lds, int tid) {
    const int lane = tid & 63, wave = __builtin_amdgcn_readfirstlane(tid >> 6), r32 = lane & 31, hi = lane >> 5;
    const int g = item % AG, ck = item / AG, tok0 = ck * CH;
    LAS f32x2* ms = (LAS f32x2*)(lds + SG_MS_OFF);
    if (tid < CH) { const f32x4* st = (const f32x4*)(stats + (size_t)(tok0 + tid) * 32); float s = 0.f, q = 0.f;
#pragma unroll
        for (int i = 0; i < 8; ++i) { const f32x4 v = st[i]; s += v[0] + v[2]; q += v[1] + v[3]; }
        const float mu = s * (1.f / 1024.f); const float var = fmaxf(q * (1.f / 1024.f) - mu * mu, 0.f);
        ms[tid] = (f32x2){mu, 1.f / sqrtf(var + EPS)}; }
    __syncthreads();
    {
        const int c = tid & 31, ch0 = g * AGW + c * 8;
        const f32x4 g0 = *(const f32x4*)(ln_g + ch0), g1 = *(const f32x4*)(ln_g + ch0 + 4), b0 = *(const f32x4*)(ln_b + ch0), b1 = *(const f32x4*)(ln_b + ch0 + 4);
#pragma unroll
        for (int k = 0; k < 8; ++k) {
            const int j = (tid >> 5) + 16 * k;
            const u32x4 raw = *(const u32x4*)(R + (size_t)(tok0 + j) * LDR + RC_V + ch0);
            const f32x2 m = ms[j];
            f32x4 v0 = (f32x4){bflo(raw.x), bfhi(raw.x), bflo(raw.y), bfhi(raw.y)}, v1 = (f32x4){bflo(raw.z), bfhi(raw.z), bflo(raw.w), bfhi(raw.w)};
            v0 = (v0 - m.x) * m.y * g0 + b0; v1 = (v1 - m.x) * m.y * g1 + b1;
            *(LAS u32x4*)(lds + SG_V_OFF + (c >> 2) * 8192 + j * 64 + (c & 3) * 16) = pack8(v0, v1);
        }
    }
    __syncthreads();
    f32x16 acc[4];
#pragma unroll
    for (int a = 0; a < 4; ++a)
#pragma unroll
        for (int r = 0; r < 16; ++r) acc[a][r] = a_bs[g * CH + 32 * a + crow(r, hi)];
    {
        const int q4 = (lane & 15) >> 2, pp = lane & 3, cb = (lane >> 4) & 1;
        const LAS unsigned char* vp = lds + SG_V_OFF + wave * 8192 + (8 * hi + q4) * 64 + cb * 32 + pp * 8;
        const bf16_t* wp = aws + ((size_t)g * CH + r32) * CH + 8 * hi;
#pragma unroll
        for (int s = 0; s < 8; ++s) {
            const s16x4 lo = vtr(vp + s * 1024), hh = vtr(vp + s * 1024 + 256);
            const bf16x8 vf = (bf16x8){lo[0], lo[1], lo[2], lo[3], hh[0], hh[1], hh[2], hh[3]};
#pragma unroll
            for (int a = s >> 1; a < 4; ++a) { const bf16x8 wf = *(const bf16x8*)(wp + (size_t)(32 * a) * CH + 16 * s); acc[a] = __builtin_amdgcn_mfma_f32_32x32x16_bf16(wf, vf, acc[a], 0, 0, 0); }
        }
    }
    __syncthreads();
    LAS float* sl = (LAS float*)(lds + SG_V_OFF);
#pragma unroll
    for (int half = 0; half < 2; ++half) {
#pragma unroll
        for (int a2 = 0; a2 < 2; ++a2)
#pragma unroll
            for (int r = 0; r < 16; ++r) sl[(32 * a2 + crow(r, hi)) * AGW + 32 * wave + r32] = acc[2 * half + a2][r];
        __syncthreads();
#pragma unroll
        for (int k = 0; k < 4; ++k) {
            const int q = tid + 512 * k, il = q >> 5, c = q & 31;
            const f32x4 s0 = *(const LAS f32x4*)(sl + il * AGW + c * 8), s1 = *(const LAS f32x4*)(sl + il * AGW + c * 8 + 4);
            bf16_t* up = R + (size_t)(tok0 + 64 * half + il) * LDR + RC_U + g * AGW + c * 8;
            const u32x4 pp_ = *(const u32x4*)up;
            const f32x4 y0 = (f32x4){bflo(pp_.x), bfhi(pp_.x), bflo(pp_.y), bfhi(pp_.y)} * s0, y1 = (f32x4){bflo(pp_.z), bfhi(pp_.z), bflo(pp_.w), bfhi(pp_.w)} * s1;
            *(u32x4*)up = pack8(y0, y1);
        }
        __syncthreads();
    }
}

constexpr int NWAVES = 8;
#ifndef PROBE_DELAY
#define PROBE_DELAY -1
#endif
constexpr int RING_BYTES = 131072;
constexpr int GCONST_OFF = RING_BYTES;
constexpr int LDSCTL_OFF = 147456 - 1024, MISC_OFF = LDSCTL_OFF + 320;
constexpr int LDS_BYTES = 147456;

struct Args {
    const float* x; const float* norm_g; const float* w_in; const float* a_ws; const float* a_bs; const float* a_ln_g; const float* a_ln_b;
    const float* qn; const float* kn; const float* w_oa; const float* w_ob; const float* w_out;
    float* out; unsigned char* ws;
};

constexpr int P0_TP = 68, P0_SCR = 64 * P0_TP * 4, P0_ROWS = M / 4;
constexpr int P0_NWA = (D / 64) * 96, P0_L0 = P0_ROWS + P0_NWA, P0_L1 = (D / 64) * 64, P0_IOA = (D / 64) * (D / 64), P0_IOB = (BW / 64) * (D / 64), P0_L2 = 2 * P0_IOA + P0_IOB;
struct P0Item { const float* src; bf16_t* dst; unsigned char* dst8; int N, ldo, rskip; bool rows, fp8; };
__device__ __forceinline__ P0Item p0_item(int list, int it, const float* x, const float* w_in, const float* w_oa, const float* w_ob, const float* w_out, bf16_t* xn, bf16_t* win, bf16_t* wcat, bf16_t* wout, unsigned char* xn8) {
    P0Item q; q.rows = (list == 0) && it < P0_ROWS; q.N = D; q.ldo = D; q.fp8 = false; q.dst8 = xn8; q.rskip = 0;
    if (q.rows) { q.src = x + (size_t)it * 4 * D; q.dst = xn + (size_t)it * 4 * D; q.dst8 = xn8 + (size_t)it * 4 * D; return q; }
    if (list < 2) {
        const int r = list == 0 ? it - P0_ROWS : it, nt_ = list == 0 ? 96 : 64, kb = r / nt_, j = r % nt_;
        const int nb = list == 0 ? (j < 80 ? 48 + j : 64 + j) : (j < 48 ? j : 80 + j);
        q.N = NIN; q.src = w_in + (size_t)(64 * kb) * NIN + 64 * nb; q.dst = win + (size_t)win_row_of_col(64 * nb) * D + 64 * kb;
        q.rskip = (list == 1 && nb < 48 && (nb < 16 || nb >= 32)) ? 32 : 0;
        q.fp8 = list == 0; q.dst8 = (unsigned char*)win + (size_t)win_row_of_col(64 * nb) * D + 64 * kb;
        return q;
    }
    int r = it;
    if (r < P0_IOA) { const int kb = r / (D / 64), nb = r % (D / 64); q.ldo = KCAT; q.src = w_oa + (size_t)(64 * kb) * D + 64 * nb; q.dst = wcat + (size_t)(64 * nb) * KCAT + 64 * kb; return q; } r -= P0_IOA;
    if (r < P0_IOB) { const int kb = r / (D / 64), nb = r % (D / 64); q.ldo = KCAT; q.src = w_ob + (size_t)(64 * kb) * D + 64 * nb; q.dst = wcat + (size_t)(64 * nb) * KCAT + D + 64 * kb; return q; } r -= P0_IOB;
    { const int kb = r / (D / 64), nb = r % (D / 64); q.src = w_out + (size_t)(64 * kb) * D + 64 * nb; q.dst = wout + (size_t)(64 * nb) * D + 64 * kb; return q; }
}
__device__ __forceinline__ void p0_load(const P0Item& q, f32x4 (&v)[16], int lane) {
    if (q.rows) {
#pragma unroll
        for (int i = 0; i < 16; ++i) v[i] = __builtin_nontemporal_load((const f32x4*)(q.src + (size_t)(i >> 2) * D) + lane + 64 * (i & 3));
    } else {
#pragma unroll
        for (int i = 0; i < 16; ++i) v[i] = __builtin_nontemporal_load((const f32x4*)(q.src + (size_t)(4 * i + (lane >> 4)) * q.N + 4 * (lane & 15)));
    }
}
__device__ __forceinline__ void p0_process(const P0Item& q, const f32x4 (&v)[16], const float* g, LAS float* scr, int lane) {
    if (q.rows) {
#pragma unroll
        for (int r = 0; r < 4; ++r) {
            const float s = (sumsq4(v[4 * r]) + sumsq4(v[4 * r + 1])) + (sumsq4(v[4 * r + 2]) + sumsq4(v[4 * r + 3]));
            const float rstd = 1.f / sqrtf(wave_sum(s) * (1.f / D) + EPS);
            unsigned long long* o8 = (unsigned long long*)(q.dst + (size_t)r * D) + lane;
#pragma unroll
            for (int j = 0; j < 4; ++j) { const f32x4 y = v[4 * r + j] * rstd * ((const f32x4*)g)[lane + 64 * j]; o8[64 * j] = (unsigned long long)pk2(y.x, y.y) | ((unsigned long long)pk2(y.z, y.w) << 32);
                int w8 = __builtin_amdgcn_cvt_pk_fp8_f32(y.x, y.y, 0, false); w8 = __builtin_amdgcn_cvt_pk_fp8_f32(y.z, y.w, w8, true); ((int*)(q.dst8 + (size_t)r * D))[lane + 64 * j] = w8; }
        }
    } else {
#pragma unroll
        for (int i = 0; i < 16; ++i) *(LAS f32x4*)(scr + (4 * i + (lane >> 4)) * P0_TP + 4 * (lane & 15)) = v[i];
        LDS_WAIT(); asm volatile("" ::: "memory");
        if (q.fp8) {
            const int c4 = lane & 3;
#pragma unroll
            for (int j = 0; j < 4; ++j) { const int n = (lane >> 2) + 16 * j; const LAS float* s = scr + (16 * c4) * P0_TP + n; u32x4 o;
#define P0_F8(k0_) ({ int w_ = __builtin_amdgcn_cvt_pk_fp8_f32(s[(k0_) * P0_TP] * WA8_SCALE, s[((k0_) + 1) * P0_TP] * WA8_SCALE, 0, false); (unsigned)__builtin_amdgcn_cvt_pk_fp8_f32(s[((k0_) + 2) * P0_TP] * WA8_SCALE, s[((k0_) + 3) * P0_TP] * WA8_SCALE, w_, true); })
                o.x = P0_F8(0); o.y = P0_F8(4); o.z = P0_F8(8); o.w = P0_F8(12);
#undef P0_F8
                *(u32x4*)(q.dst8 + (size_t)n * D + 16 * c4) = o; }
            LDS_WAIT(); asm volatile("" ::: "memory");
            return;
        }
        const int c = lane & 7;
#pragma unroll
        for (int j = 0; j < 8; ++j) { const int n = (lane >> 3) + 8 * j; const LAS float* s = scr + (8 * c) * P0_TP + n;
            v4u o; o.x = pk2(s[0 * P0_TP], s[1 * P0_TP]); o.y = pk2(s[2 * P0_TP], s[3 * P0_TP]); o.z = pk2(s[4 * P0_TP], s[5 * P0_TP]); o.w = pk2(s[6 * P0_TP], s[7 * P0_TP]);
            *(GAS v4u*)(q.dst + (size_t)(n + q.rskip * (n >> 5)) * q.ldo + 8 * c) = o; }
        LDS_WAIT(); asm volatile("" ::: "memory");
    }
}

__global__ void __launch_bounds__(NWAVES * 64, 2) fwd_megakernel(Args a) {
    extern __shared__ __attribute__((aligned(16))) unsigned char lds_raw[];
    LAS unsigned char* lds = (LAS unsigned char*)lds_raw;
    volatile LAS unsigned* MISC = (volatile LAS unsigned*)(lds + MISC_OFF);
    const int tid = threadIdx.x, lane = tid & 63, wave = __builtin_amdgcn_readfirstlane(tid >> 6);
    const int G = gridDim.x, bx = blockIdx.x, vcu = (G % 8 == 0) ? (bx % 8) * (G / 8) + bx / 8 : bx;
    unsigned char* ws = a.ws;
    gu32* ctl = (gu32*)(ws + WS_CTL); float* ctlf = (float*)(ws + WS_CTL);
    bf16_t* win = (bf16_t*)(ws + WS_WIN); bf16_t* wcat = (bf16_t*)(ws + WS_WCAT); bf16_t* wout = (bf16_t*)(ws + WS_WOUT);
    bf16_t* aws = (bf16_t*)(ws + WS_AWS); float* den = (float*)(ws + WS_DEN); float* stats = (float*)(ws + WS_STATS);
    bf16_t* xn = (bf16_t*)(ws + WS_XN); bf16_t* R = (bf16_t*)(ws + WS_R); unsigned char* xn8 = ws + WS_XN8;
    for (int u = tid; u < (LDS_BYTES - LDSCTL_OFF) / 4; u += NWAVES * 64) ((LAS unsigned*)(lds + LDSCTL_OFF))[u] = 0u;
    __syncthreads();
    XcdBarrier bar = xcd_barrier_post((unsigned*)ctl + CW_BAR, MISC + 8);
    const bool cl = (G == 256); const int pmc = 8 * (bx & 7) + ((bx >> 3) & 7), rc = bx >> 6;
    if (tid == 0) __hip_atomic_store((unsigned*)ctl + 3072 + bx, xb_xcc_id() + 1u, __ATOMIC_RELAXED, __HIP_MEMORY_SCOPE_AGENT);
#define SEAM_CL(k, n) do { xcd_barrier_arrive(); if (cl) cl_barrier_wait((unsigned*)ctl, bar.bar, pmc, 4u * (n)); else xcd_barrier_wait(bar); \
        if (PROBE_DELAY == (k)) { const unsigned long long t1_ = rt(); while (rt() < t1_ + (t1_ - tph_)) __builtin_amdgcn_s_sleep(8); } if (PROBE_DELAY >= 0) tph_ = rt(); } while (0)
    const int gw = vcu * NWAVES + wave, NGW = G * NWAVES;
    unsigned long long tph_ = (PROBE_DELAY >= 0) ? rt() : 0ull;
#define SEAM(k) do { xcd_barrier(bar); if (PROBE_DELAY == (k)) { const unsigned long long t1_ = rt(); while (rt() < t1_ + (t1_ - tph_)) __builtin_amdgcn_s_sleep(8); } \
        if (PROBE_DELAY >= 0) tph_ = rt(); } while (0)

#define BARRIER_WINDOW(L, n) do { xcd_barrier_arrive(); \
        if (wave != 0) { LAS float* scr_ = (LAS float*)(lds + wave * P0_SCR); f32x4 vw_[16]; \
            for (int it_ = vcu * 7 + wave - 1; it_ < (n); it_ += G * 7) { const P0Item q_ = p0_item(it_ < P0_L1 ? 1 : 2, it_ < P0_L1 ? it_ : it_ - P0_L1, a.x, a.w_in, a.w_oa, a.w_ob, a.w_out, xn, win, wcat, wout, xn8); p0_load(q_, vw_, lane); p0_process(q_, vw_, a.norm_g, scr_, lane); } } \
        xcd_barrier_wait(bar); } while (0)
#define SEAM_W(k, L, n) do { BARRIER_WINDOW(L, n); if (PROBE_DELAY == (k)) { const unsigned long long t1_ = rt(); while (rt() < t1_ + (t1_ - tph_)) __builtin_amdgcn_s_sleep(8); } \
        if (PROBE_DELAY >= 0) tph_ = rt(); } while (0)
    {
        LAS float* scr = (LAS float*)(lds + wave * P0_SCR);
#define P0_ITEM(i) p0_item(0, (i), a.x, a.w_in, a.w_oa, a.w_ob, a.w_out, xn, win, wcat, wout, xn8)
        f32x4 va[16], vb[16];
        P0Item qa = P0_ITEM(0), qb = qa;
        for (int it = gw; it < P0_NWA; it += NGW) { qa = P0_ITEM(P0_ROWS + it); p0_load(qa, va, lane); p0_process(qa, va, a.norm_g, scr, lane); }
        xcd_barrier_arrive(); xcd_barrier_signal(bar);
        const int rbase = pmc * 64 + rc * 16 + wave * 2;
        for (int k = 0; ; k += 2) {
            const int r0 = cl ? rbase + k : gw + k * NGW, r1 = cl ? r0 + 1 : r0 + NGW;
            const bool h0 = cl ? k < 2 : r0 < P0_ROWS, h1 = cl ? k < 2 : r1 < P0_ROWS;
            if (!h0) break;
            qa = P0_ITEM(r0); p0_load(qa, va, lane);
            if (h1) { qb = P0_ITEM(r1); p0_load(qb, vb, lane); }
            p0_process(qa, va, a.norm_g, scr, lane);
            if (h1) p0_process(qb, vb, a.norm_g, scr, lane);
        }
#undef P0_ITEM
        for (int idx = vcu * 512 + tid; idx < AG * CH * CH; idx += G * 512) { const int i = (idx / CH) % CH, j = idx % CH; aws[idx] = (bf16_t)f2bf(j <= i ? a.a_ws[idx] : 0.f); }
        if (bx == 0 && wave == 0) {
            float c = 0.f;
            for (int p = 0; p < 3; ++p) { const float mq = wave_max(fabsf(a.qn[p * 64 + lane])), mk = wave_max(fabsf(a.kn[p * 64 + lane])); c = fmaxf(c, mq * mk); }
            if (lane == 0) ctlf[CONST_OFF] = c * 64.f * QSCALE * 1.001f;
        }
    }
    xcd_barrier_arrive(); xcd_barrier_finish(bar);
    if (cl) cl_barrier_wait((unsigned*)ctl, bar.bar, pmc, 4u, 2); else xcd_barrier_wait(bar);
    if (PROBE_DELAY == 0) { const unsigned long long t1_ = rt(); while (rt() < t1_ + (t1_ - tph_)) __builtin_amdgcn_s_sleep(8); }
    if (PROBE_DELAY >= 0) tph_ = rt();
    for (int i = tid; i < 384; i += NWAVES * 64) ((LAS float*)(lds + GCONST_OFF))[i] = i < 192 ? a.qn[i] : a.kn[i - 192];
    __syncthreads();

    {
        pg8::Gemm g{(const bf16_t*)xn8, win, D / 2, D / 2, D / 2}; pg8::StaticOrder S; S.init(M, NA, G, bx);
        EpiA E{R, (const LAS float*)(lds + GCONST_OFF)};
        pg8::gemm_phase<EpiA, pg8::StaticOrder, true, true>(lds, g, S, E);
    }
    SEAM_W(1, 1, P0_L1 + P0_L2);

    {
        const float cneg = -ctlf[CONST_OFF];
        attn_phase<false>(vcu, G, 1024, R, den, cneg, lds, tid);
        xcd_barrier_arrive(); xcd_barrier_signal(bar);
        if (PROBE_DELAY >= 0) tph_ = rt();
        attn_phase<true>(vcu, G, 512, R, den, cneg, lds, tid, bar.bar + XB_TOPGEN, MISC + 8);
    }
    xcd_barrier_arrive(); xcd_barrier_signal(bar);
    if (PROBE_DELAY >= 0) tph_ = rt();

    {
        pg8::Gemm g{xn, win + (size_t)NA * D, D, D, D}; pg8::StaticOrder S; S.init(M, NB, G, bx);
        EpiB E{R, stats, bar.bar + XB_TOPGEN, MISC + 8};
        pg8::gemm_phase<EpiB, pg8::StaticOrder, true, true>(lds, g, S, E);
    }
    SEAM_CL(4, 1);

    for (int k = 0; k < ((M / CH) * AG + G - 1) / G; ++k) { const int item = cl ? (2 * pmc + k) * AG + rc : vcu + k * G; if (item < (M / CH) * AG) sgu_unit(item, R, stats, aws, a.a_bs, a.a_ln_g, a.a_ln_b, lds, tid); }
    SEAM_CL(5, 2);

    {
        pg8::Gemm g{R + RC_U, wcat, LDR, KCAT, KCAT}; pg8::SplitOrder S; S.init(M, D, G, bx);
        EpiM E{R};
        pg8::gemm_phase<EpiM, pg8::SplitOrder, true, true>(lds, g, S, E);
    }
    {
        pg8::Gemm g{R + RC_V, wout, LDR, D, D}; pg8::StaticOrder S; S.init(M, D, G, bx);
        EpiOut E{a.x, a.out};
        f32x4 acc[2][2][4][2]; pg8::Unit u0; const bool any = S.next(0, u0);
        xcd_barrier_arrive();
        if (any && wave != 0) E.preload(acc, u0, wave >> 2, wave & 3, lane & 15, lane >> 4);
        if (cl) cl_barrier_wait((unsigned*)ctl, bar.bar, pmc, 12u); else xcd_barrier_wait(bar);
        if (PROBE_DELAY == 6) { const unsigned long long t1_ = rt(); while (rt() < t1_ + (t1_ - tph_)) __builtin_amdgcn_s_sleep(8); }
        if (PROBE_DELAY >= 0) tph_ = rt();
        if (any && wave == 0) E.preload(acc, u0, wave >> 2, wave & 3, lane & 15, lane >> 4);
        pg8::gemm_phase_impl<EpiOut, pg8::StaticOrder, true, true, true>(lds, g, S, E, acc);
    }
    if (PROBE_DELAY == 7) { const unsigned long long t1_ = rt(); while (rt() < t1_ + (t1_ - tph_)) __builtin_amdgcn_s_sleep(8); }
}

extern "C" void kernel_launch(void* const* d_in, const int* in_sizes, int n_in, void* d_out, int out_size, void* d_ws, size_t ws_size, hipStream_t stream) {
    static int grid = 0;
    if (grid == 0) {
        if (n_in != 12 || in_sizes[0] != M * D || out_size != M * D || ws_size < WS_END) { fprintf(stderr, "kernel_launch: unexpected shapes (n_in %d, in0 %d, out %d, ws %zu); nothing launched\n", n_in, n_in > 0 ? in_sizes[0] : -1, out_size, ws_size); grid = -1; return; }
        int dev = 0, cus = 0, per_cu = 0;
        if (hipGetDevice(&dev) != hipSuccess || hipDeviceGetAttribute(&cus, hipDeviceAttributeMultiprocessorCount, dev) != hipSuccess) { fprintf(stderr, "kernel_launch: device query failed\n"); grid = -1; return; }
        if (hipFuncSetAttribute((const void*)fwd_megakernel, hipFuncAttributeMaxDynamicSharedMemorySize, LDS_BYTES) != hipSuccess) { fprintf(stderr, "kernel_launch: hipFuncSetAttribute failed\n"); grid = -1; return; }
        if (hipOccupancyMaxActiveBlocksPerMultiprocessor(&per_cu, (const void*)fwd_megakernel, NWAVES * 64, LDS_BYTES) != hipSuccess || per_cu < 1)
            fprintf(stderr, "kernel_launch: note: occupancy query reports %d workgroups per CU\n", per_cu);
        (void)hipGetLastError();
        grid = cus;
    }
    if (grid < 0) return;
    if (hipMemsetAsync((char*)d_ws + WS_CTL, 0, 32768, stream) != hipSuccess) { fprintf(stderr, "kernel_launch: hipMemsetAsync failed\n"); return; }
    Args a{};
    a.x = (const float*)d_in[0]; a.norm_g = (const float*)d_in[1]; a.w_in = (const float*)d_in[2]; a.a_ws = (const float*)d_in[3]; a.a_bs = (const float*)d_in[4];
    a.a_ln_g = (const float*)d_in[5]; a.a_ln_b = (const float*)d_in[6]; a.qn = (const float*)d_in[7]; a.kn = (const float*)d_in[8];
    a.w_oa = (const float*)d_in[9]; a.w_ob = (const float*)d_in[10]; a.w_out = (const float*)d_in[11];
    a.out = (float*)d_out; a.ws = (unsigned char*)d_ws;
    hipLaunchKernelGGL(fwd_megakernel, dim3(grid), dim3(NWAVES * 64), LDS_BYTES, stream, a);
    const hipError_t le = hipPeekAtLastError();
    if (le != hipSuccess) fprintf(stderr, "kernel_launch: launch failed: %s\n", hipGetErrorName(le));
}
```

```cpp
#include <hip/hip_runtime.h>
#include <cstdint>
#include <cstdio>

typedef unsigned short bf16_t;
typedef short bf16x8 __attribute__((ext_vector_type(8)));
typedef float f32x4 __attribute__((ext_vector_type(4)));
typedef float f32x2 __attribute__((ext_vector_type(2)));
typedef unsigned u32x4 __attribute__((ext_vector_type(4)));

constexpr int BATCH = 4, SEQ = 4096, D = 1024, M = BATCH * SEQ;
constexpr int NIN = 10240, NA = 6144, NB = 4096, LDR = 5632;
constexpr int RC_V = 1024, RC_GATE = 2048, RC_U = 4096, RC_YB = 5120, RC_BGATE = 4608, KCAT = 1536;
__host__ __device__ __forceinline__ int sa_col(int j) { return j < 2 ? j * 256 : 3072 + (j - 2) * 256; }
__host__ __device__ __forceinline__ int sb_col(int j) { return j < 2 ? 512 + j * 256 : 3584 + (j - 2) * 256; }
constexpr int CH = 128, AG = 4, AGW = 256;
constexpr int NH = 8, HD = 64, BW = 512;
constexpr float EPS = 1e-6f;
constexpr float LOG2E = 1.4426950408889634f;
constexpr float QSCALE = 0.125f * LOG2E;

constexpr size_t MiB = 1u << 20;
constexpr size_t WS_CTL = 0, CTL_ZERO_BYTES = 1 * MiB;
constexpr float WA8_SCALE = 1.f;
constexpr size_t WS_WIN = 2 * MiB;
constexpr size_t WS_WCAT = 22 * MiB;
constexpr size_t WS_WOUT = 25 * MiB;
constexpr size_t WS_AWS = 27 * MiB;
constexpr size_t WS_DEN = 28 * MiB;
constexpr size_t WS_STATS = 29 * MiB;
constexpr size_t WS_XN = 32 * MiB;
constexpr size_t WS_R = 64 * MiB;
constexpr size_t WS_XN8 = 240 * MiB;
constexpr size_t WS_END = 256 * MiB;
constexpr int CW_BAR = 4096;
constexpr int CONST_OFF = 1024;

__device__ __forceinline__ unsigned f2bf(float f) { unsigned u = __builtin_bit_cast(unsigned, f); return (u + 0x7fffu + ((u >> 16) & 1u)) >> 16; }
typedef __bf16 bf16x2_t __attribute__((ext_vector_type(2)));
__device__ __forceinline__ unsigned pk2(float lo, float hi) { const f32x2 v = {lo, hi}; return __builtin_bit_cast(unsigned, __builtin_convertvector(v, bf16x2_t)); }
__device__ __forceinline__ float bf2f(unsigned short h) { return __builtin_bit_cast(float, (unsigned)h << 16); }
__device__ __forceinline__ float bflo(unsigned w) { return __builtin_bit_cast(float, w << 16); }
__device__ __forceinline__ float bfhi(unsigned w) { return __builtin_bit_cast(float, w & 0xffff0000u); }
__device__ __forceinline__ float sigmoid_f(float x) { return __builtin_amdgcn_rcpf(1.f + __builtin_amdgcn_exp2f(-x * LOG2E)); }
__device__ __forceinline__ float silu_f(float x) { return x * sigmoid_f(x); }
__device__ __forceinline__ float gelu_silu_f(float u, float g) { const float k = 0.7978845608028654f * (u + 0.044715f * u * u * u); const float ea = __builtin_amdgcn_exp2f(-2.f * LOG2E * k), eb = __builtin_amdgcn_exp2f(-LOG2E * g); return (u * g) * __builtin_amdgcn_rcpf((1.f + ea) * (1.f + eb)); }
__device__ __forceinline__ float gelu_f(float x) { const float u = 0.7978845608028654f * (x + 0.044715f * x * x * x); return x * sigmoid_f(2.f * u); }
__device__ __forceinline__ float wave_sum(float v) {
#pragma unroll
    for (int o = 1; o < 64; o <<= 1) v += __shfl_xor(v, o);
    return v;
}
__device__ __forceinline__ float wave_max(float v) {
#pragma unroll
    for (int o = 1; o < 64; o <<= 1) v = fmaxf(v, __shfl_xor(v, o));
    return v;
}
__host__ __device__ __forceinline__ int win_row_of_col(int c) { return c < 1024 ? 7168 + 2 * c : (c < 2048 ? c + 5120 : (c < 3072 ? 7168 + 2 * (c - 2048) + 32 : (c < 8192 ? c - 3072 : (c < 9216 ? c + 1024 : c - 4096)))); }

namespace pg8 {
#define PG8_LAS __attribute__((address_space(3)))
typedef unsigned short bf16_t;
typedef short bf16x8 __attribute__((ext_vector_type(8)));
typedef float f32x4 __attribute__((ext_vector_type(4)));
typedef unsigned u32x4 __attribute__((ext_vector_type(4)));
constexpr int BM = 256, BK = 64, HALF = 128, HTB = HALF * BK * 2  , STAGE_BYTES = 8 * HTB, NXCD = 8, WGM = 8;

__host__ __device__ __forceinline__ int lds_byte(int r, int c) { const int st = (r >> 4) * 2 + (c >> 5), rr = r & 15, cc = c & 31, ob = rr * 64 + cc * 2; return st * 1024 + (ob ^ (((ob >> 9) & 1) << 5)); }
__host__ __device__ __forceinline__ void stage_rc(int b, int& R, int& C) { const int st = b / 1024, sb = b % 1024, swz = sb ^ (((sb >> 9) & 1) << 5); R = (st >> 1) * 16 + swz / 64; C = (st & 1) * 32 + (swz % 64) / 2; }
__host__ __device__ __forceinline__ int perm32(int rho) { const int n = rho >> 4, i = rho & 15; return 8 * (i >> 2) + 4 * n + (i & 3); }

struct Unit { int pm, pn, sub; };
struct Gemm { const bf16_t* A; const bf16_t* Bt; int lda, ldb, K; };

struct StaticOrder {
    int nM, nN, nwg, G, c;
    __host__ __device__ void init(int M, int N, int G_, int c_) { nM = M / BM; nN = N / BM; nwg = nM * nN; G = G_; c = c_; }
    __host__ __device__ bool next(int i, Unit& u) const {
        const long L = (long)i * G + c; if (L >= nwg) return false;
        int wgid = (int)L; { const int q = nwg / NXCD, r = nwg % NXCD, xcd = wgid % NXCD, off = wgid / NXCD; wgid = (xcd < r ? xcd * (q + 1) : r * (q + 1) + (xcd - r) * q) + off; }
        const int nig = WGM * nN, gid = wgid / nig, fm = gid * WGM, gsz = (nM - fm) < WGM ? (nM - fm) : WGM;
        u.pm = fm + ((wgid % nig) % gsz); u.pn = (wgid % nig) / gsz; u.sub = 0; return true;
    }
    __device__ __forceinline__ void a_ready(const Unit&) const {}
    __device__ __forceinline__ void done(const Unit&) const {}
};
struct SplitOrder {
    StaticOrder base; unsigned* cw; unsigned target; mutable bool armed;
    __host__ __device__ void init(int M, int N, int G_, int c_) { base.init(M, N, G_, c_); cw = nullptr; target = 0u; armed = false; }
    __host__ __device__ bool next(int i, Unit& u) const { if (!base.next(i >> 1, u)) return false; u.sub = i & 1; return true; }
    __device__ __forceinline__ void a_ready(const Unit& u) const {
        if (armed) { armed = false;
            if (threadIdx.x == 0) { unsigned sp = 0u; while (__hip_atomic_load(cw, __ATOMIC_RELAXED, __HIP_MEMORY_SCOPE_AGENT) < target) { __builtin_amdgcn_s_sleep(1); if (++sp > (1u << 22)) break; }
                __builtin_amdgcn_fence(__ATOMIC_ACQUIRE, "agent"); asm volatile("s_waitcnt vmcnt(0)" ::: "memory"); }
            __syncthreads(); }
    }
    __device__ __forceinline__ void done(const Unit&) const {}
};

template <class Epi, class Sched, bool ALIGN_EPI, bool SP2, bool EXTACC>
__device__ __forceinline__ void gemm_phase_impl(PG8_LAS unsigned char* lds, const Gemm g, const Sched& S, const Epi& E, f32x4 (&acc)[2][2][4][2]) {
    int tid_ = threadIdx.x; asm volatile("" : "+v"(tid_));
    const int tid = tid_, wid = __builtin_amdgcn_readfirstlane(tid >> 6), lane = tid & 63, wr = wid >> 2, wc = wid & 3, fr = lane & 15, fq = lane >> 4;
    const int K = g.K, nt = K / BK;
    unsigned voffA[2], voffB[2];
#pragma unroll
    for (int i = 0; i < 2; ++i) { int R, C; stage_rc(tid * 16 + i * 8192, R, C); const int Rb = 64 * (R >> 5) + perm32(R & 31);
        voffA[i] = (unsigned)(R * g.lda + C) * 2u; voffB[i] = (unsigned)(Rb * g.ldb + C) * 2u; }
    const size_t kstep = (size_t)(BK * 2);
    const size_t hstepA = (size_t)HALF * g.lda * 2;
    const size_t hstepB = (size_t)32 * g.ldb * 2;
    const size_t tstepA = (size_t)BM * g.lda * 2, tstepB = (size_t)BM * g.ldb * 2;
    const unsigned ldsw = (unsigned)wid * 1024u;
    const int aoff = lds_byte(wr * 64 + fr, fq * 8), boff = lds_byte(wc * 32 + fr, fq * 8);
#define PG8_SA(b, h) (((b) * 2 + (h)) * HTB)
#define PG8_SB(b, h) ((4 + (b) * 2 + (h)) * HTB)
#define PG8_STAGE(bufoff, gbase, voff) do { _Pragma("unroll") for (int _i = 0; _i < 2; ++_i) \
        __builtin_amdgcn_global_load_lds((const unsigned*)((const char*)(gbase) + (voff)[_i]), (PG8_LAS unsigned*)(lds + (bufoff) + ldsw + _i * 8192), 16, 0, 0); } while (0)
typedef int pg8_v8i __attribute__((ext_vector_type(8)));
typedef int pg8_v4i __attribute__((ext_vector_type(4)));
#define PG8_LD32(p_) ({ const pg8_v4i l_ = *(const PG8_LAS pg8_v4i*)(p_), h_ = *(const PG8_LAS pg8_v4i*)((p_) + 1024); __builtin_shufflevector(l_, h_, 0, 1, 2, 3, 4, 5, 6, 7); })
#define PG8_LDA(dst, b, h) do { if constexpr (Epi::FP8) { _Pragma("unroll") for (int m = 0; m < 4; ++m) dst##8[m] = PG8_LD32(lds + PG8_SA(b, h) + aoff + m * 2048); } \
        else { _Pragma("unroll") for (int m = 0; m < 4; ++m) _Pragma("unroll") for (int k = 0; k < 2; ++k) dst[m][k] = *(const PG8_LAS bf16x8*)(lds + PG8_SA(b, h) + aoff + m * 2048 + k * 1024); } } while (0)
#define PG8_LDB(dst, b, h) do { if constexpr (Epi::FP8) { _Pragma("unroll") for (int n = 0; n < 2; ++n) dst##8[n] = PG8_LD32(lds + PG8_SB(b, h) + boff + n * 2048); } \
        else { _Pragma("unroll") for (int n = 0; n < 2; ++n) _Pragma("unroll") for (int k = 0; k < 2; ++k) dst[n][k] = *(const PG8_LAS bf16x8*)(lds + PG8_SB(b, h) + boff + n * 2048 + k * 1024); } } while (0)
#define PG8_MMA(ai, bj, At, Bt) do { __builtin_amdgcn_s_setprio(1); \
        if constexpr (Epi::FP8) { asm volatile("s_nop 4"); _Pragma("unroll") for (int m = 0; m < 4; ++m) _Pragma("unroll") for (int n = 0; n < 2; ++n) \
            asm volatile("s_nop 1\n\tv_mfma_scale_f32_16x16x128_f8f6f4 %0, %1, %2, %0, %3, %4 op_sel_hi:[0,0,0] cbsz:2 blgp:2" : "+v"(acc[ai][bj][m][n]) \
                : "v"(__builtin_shufflevector(Bt##8[n], Bt##8[n], 0, 1, 2, 3, 4, 5)), "v"(__builtin_shufflevector(At##8[m], At##8[m], 0, 1, 2, 3, 4, 5)), "v"(Bt##8[n][6]), "v"(At##8[m][6])); \
            } \
        else { _Pragma("unroll") for (int m = 0; m < 4; ++m) _Pragma("unroll") for (int n = 0; n < 2; ++n) _Pragma("unroll") for (int k = 0; k < 2; ++k) \
            acc[ai][bj][m][n] = __builtin_amdgcn_mfma_f32_16x16x32_bf16(Bt[n][k], At[m][k], acc[ai][bj][m][n], 0, 0, 0); } \
        __builtin_amdgcn_s_setprio(0); } while (0)
#define PG8_WAIT_V(n) asm volatile("s_waitcnt vmcnt(" #n ")" ::: "memory")
#define PG8_WAIT_L(n) asm volatile("s_waitcnt lgkmcnt(" #n ")" ::: "memory")
#define PG8_BAR __builtin_amdgcn_s_barrier()
#define PG8_SCHED __builtin_amdgcn_sched_barrier(0)
    Unit cur, nxt; int ui = 0;
    if (!S.next(0, cur)) return;
    if constexpr (EXTACC) {}
    else if constexpr (Epi::PRELOAD) E.preload(acc, cur, wr, wc, fr, fq);
    else {
#pragma unroll
    for (int a = 0; a < 2; ++a)
#pragma unroll
        for (int b = 0; b < 2; ++b)
#pragma unroll
            for (int m = 0; m < 4; ++m)
#pragma unroll
                for (int n = 0; n < 2; ++n) acc[a][b][m][n] = (f32x4){0.f, 0.f, 0.f, 0.f};
    }
    bf16x8 At[4][2], B0[2][2], B1[2][2];
    pg8_v8i At8[4], B08[2], B18[2];
    const char* cA = (const char*)g.A + (size_t)cur.pm * tstepA + (Epi::SPLIT ? (size_t)cur.sub * 16 * kstep : 0); const char* cB = (const char*)g.Bt + (size_t)cur.pn * tstepB + (Epi::SPLIT ? (size_t)cur.sub * 16 * kstep : 0);
    if constexpr (!SP2) S.a_ready(cur);
    if constexpr (SP2) {
        PG8_STAGE(PG8_SB(0, 0), cB, voffB); PG8_STAGE(PG8_SB(0, 1), cB + hstepB, voffB); S.a_ready(cur); PG8_STAGE(PG8_SA(0, 0), cA, voffA); PG8_STAGE(PG8_SA(0, 1), cA + hstepA, voffA);
        if (wr == 1) PG8_BAR;
        PG8_WAIT_V(2); PG8_BAR;
        PG8_STAGE(PG8_SB(1, 0), cB + kstep, voffB); PG8_STAGE(PG8_SA(1, 0), cA + kstep, voffA); PG8_STAGE(PG8_SB(1, 1), cB + hstepB + kstep, voffB);
        PG8_WAIT_V(6); PG8_BAR;
    } else {
        PG8_STAGE(PG8_SB(0, 0), cB, voffB); PG8_STAGE(PG8_SA(0, 0), cA, voffA); PG8_STAGE(PG8_SB(0, 1), cB + hstepB, voffB); PG8_STAGE(PG8_SA(0, 1), cA + hstepA, voffA);
        if (wr == 1) PG8_BAR;
        PG8_WAIT_V(4); PG8_BAR;
        PG8_STAGE(PG8_SB(1, 0), cB + kstep, voffB); PG8_STAGE(PG8_SA(1, 0), cA + kstep, voffA); PG8_STAGE(PG8_SB(1, 1), cB + hstepB + kstep, voffB);
        PG8_WAIT_V(6); PG8_BAR;
    }
    for (;;) {
        const bool has_next = S.next(ui + 1, nxt);
        const char* nA = has_next ? (const char*)g.A + (size_t)nxt.pm * tstepA + (Epi::SPLIT ? (size_t)nxt.sub * 16 * kstep : 0) : cA; const char* nB = has_next ? (const char*)g.Bt + (size_t)nxt.pn * tstepB + (Epi::SPLIT ? (size_t)nxt.sub * 16 * kstep : 0) : cB;
        const int ntu = Epi::SPLIT ? (cur.sub ? 8 : 16) : nt;
        for (int t = 0; t < ntu; t += 2) {
            const bool last = (t == ntu - 2);
            const char* a1 = cA + (size_t)(t + 1) * kstep;
            const char* a2 = last ? nA : cA + (size_t)(t + 2) * kstep; const char* b2 = last ? nB : cB + (size_t)(t + 2) * kstep;
            const char* a3 = a2 + kstep; const char* b3 = b2 + kstep;
            if (last && has_next) S.a_ready(nxt);
            if constexpr (SP2) {
            PG8_LDB(B0, 0, 0); PG8_LDB(B1, 0, 1); PG8_SCHED; PG8_LDA(At, 0, 0); PG8_STAGE(PG8_SA(1, 1), a1 + hstepA, voffA);
            PG8_WAIT_V(8); PG8_WAIT_L(0); PG8_BAR; PG8_MMA(0, 0, At, B0); PG8_MMA(0, 1, At, B1); PG8_BAR; PG8_SCHED;
            PG8_LDA(At, 0, 1); PG8_STAGE(PG8_SB(0, 0), b2, voffB); PG8_STAGE(PG8_SB(0, 1), b2 + hstepB, voffB); PG8_STAGE(PG8_SA(0, 0), a2, voffA);
            PG8_WAIT_V(8); PG8_WAIT_L(0); PG8_BAR; PG8_MMA(1, 0, At, B0); PG8_MMA(1, 1, At, B1); PG8_BAR; PG8_SCHED;
            PG8_LDB(B0, 1, 0); PG8_LDB(B1, 1, 1); PG8_SCHED; PG8_LDA(At, 1, 0); PG8_STAGE(PG8_SA(0, 1), a2 + hstepA, voffA);
            PG8_WAIT_V(8); PG8_WAIT_L(0); PG8_BAR; PG8_MMA(0, 0, At, B0); PG8_MMA(0, 1, At, B1); PG8_BAR; PG8_SCHED;
            PG8_LDA(At, 1, 1); PG8_STAGE(PG8_SB(1, 0), b3, voffB); PG8_STAGE(PG8_SB(1, 1), b3 + hstepB, voffB); PG8_STAGE(PG8_SA(1, 0), a3, voffA);
            PG8_WAIT_V(8); PG8_WAIT_L(0); PG8_BAR; PG8_MMA(1, 0, At, B0); PG8_MMA(1, 1, At, B1); PG8_BAR; PG8_SCHED;
            } else {
            PG8_LDB(B0, 0, 0); PG8_SCHED; PG8_LDA(At, 0, 0); PG8_STAGE(PG8_SA(1, 1), a1 + hstepA, voffA);
            PG8_WAIT_L(8); PG8_BAR; PG8_WAIT_L(0); PG8_MMA(0, 0, At, B0); PG8_BAR; PG8_SCHED;
            PG8_LDB(B1, 0, 1); PG8_STAGE(PG8_SB(0, 0), b2, voffB);
            PG8_BAR; PG8_WAIT_L(0); PG8_MMA(0, 1, At, B1); PG8_BAR;
            PG8_LDA(At, 0, 1); PG8_STAGE(PG8_SA(0, 0), a2, voffA);
            PG8_BAR; PG8_WAIT_L(0); PG8_MMA(1, 0, At, B0); PG8_BAR; PG8_SCHED;
            PG8_STAGE(PG8_SB(0, 1), b2 + hstepB, voffB);
            PG8_WAIT_V(6); PG8_BAR; PG8_MMA(1, 1, At, B1); PG8_BAR;
            PG8_LDB(B0, 1, 0); PG8_SCHED; PG8_LDA(At, 1, 0); PG8_STAGE(PG8_SA(0, 1), a2 + hstepA, voffA);
            PG8_WAIT_L(8); PG8_BAR; PG8_WAIT_L(0); PG8_MMA(0, 0, At, B0); PG8_BAR; PG8_SCHED;
            PG8_LDB(B1, 1, 1); PG8_STAGE(PG8_SB(1, 0), b3, voffB);
            PG8_BAR; PG8_WAIT_L(0); PG8_MMA(0, 1, At, B1); PG8_BAR;
            PG8_LDA(At, 1, 1); PG8_STAGE(PG8_SA(1, 0), a3, voffA);
            PG8_BAR; PG8_WAIT_L(0); PG8_MMA(1, 0, At, B0); PG8_BAR; PG8_SCHED;
            PG8_STAGE(PG8_SB(1, 1), b3 + hstepB, voffB);
            PG8_WAIT_V(6); PG8_BAR; PG8_MMA(1, 1, At, B1); PG8_BAR;
            }
        }
        if constexpr (ALIGN_EPI) { if (wr == 0) PG8_BAR; }
        if constexpr (Epi::FP8) asm volatile("s_nop 15\n\ts_nop 15");
        if constexpr (Epi::GATED) { if (ui == 0) E.gate(); }
        const bool carry = Epi::SPLIT && cur.sub == 0;
        if constexpr (Epi::SPLIT) { if (carry) E.mid(acc, cur, wr, wc, fr, fq); else E(acc, cur, wr, wc, fr, fq); } else { E(acc, cur, wr, wc, fr, fq); }
        S.done(cur);
        if (!has_next) break;
        if (!carry) {
#pragma unroll
        for (int a = 0; a < 2; ++a)
#pragma unroll
            for (int b = 0; b < 2; ++b)
#pragma unroll
                for (int m = 0; m < 4; ++m)
#pragma unroll
                    for (int n = 0; n < 2; ++n) acc[a][b][m][n] = (f32x4){0.f, 0.f, 0.f, 0.f};
        }
        cur = nxt; cA = nA; cB = nB; ++ui;
        if constexpr (ALIGN_EPI) { if (wr == 1) PG8_BAR; }
    }
    PG8_WAIT_V(0);
    if constexpr (!ALIGN_EPI) { if (wr == 0) PG8_BAR; }
    PG8_BAR;
#undef PG8_SA
#undef PG8_SB
#undef PG8_STAGE
#undef PG8_LDA
#undef PG8_LDB
#undef PG8_MMA
#undef PG8_WAIT_V
#undef PG8_WAIT_L
#undef PG8_BAR
#undef PG8_SCHED
}
template <class Epi, class Sched, bool ALIGN_EPI = false, bool SP2 = false>
__device__ __forceinline__ void gemm_phase(PG8_LAS unsigned char* lds, const Gemm g, const Sched& S, const Epi& E) {
    f32x4 acc[2][2][4][2];
    gemm_phase_impl<Epi, Sched, ALIGN_EPI, SP2, false>(lds, g, S, E, acc);
}
}

typedef const f32x4 (&AccRef)[2][2][4][2];
__device__ __forceinline__ u32x4 pack8(const f32x4 a, const f32x4 b) { u32x4 w; w.x = pk2(a[0], a[1]); w.y = pk2(a[2], a[3]); w.z = pk2(b[0], b[1]); w.w = pk2(b[2], b[3]); return w; }
__device__ __forceinline__ float sum_fq(float x) {
    const auto r = __builtin_amdgcn_permlane16_swap(__float_as_uint(x), __float_as_uint(x), false, false);
    const float s = __uint_as_float(r[0]) + __uint_as_float(r[1]);
    const auto q = __builtin_amdgcn_permlane32_swap(__float_as_uint(s), __float_as_uint(s), false, false);
    return __uint_as_float(q[0]) + __uint_as_float(q[1]);
}
__device__ __forceinline__ float sumsq4(const f32x4 a) { return (a[0] * a[0] + a[1] * a[1]) + (a[2] * a[2] + a[3] * a[3]); }
__device__ __forceinline__ float sum4(const f32x4 a) { return (a[0] + a[1]) + (a[2] + a[3]); }
template <class F> __device__ __forceinline__ f32x4 map4(const f32x4 a, F f) { return (f32x4){f(a[0]), f(a[1]), f(a[2]), f(a[3])}; }
__device__ __forceinline__ f32x2 lo2(const f32x4 a) { return __builtin_shufflevector(a, a, 0, 1); }
__device__ __forceinline__ f32x2 hi2(const f32x4 a) { return __builtin_shufflevector(a, a, 2, 3); }
__device__ __forceinline__ f32x2 exp2_2(const f32x2 a) { return (f32x2){__builtin_amdgcn_exp2f(a.x), __builtin_amdgcn_exp2f(a.y)}; }
__device__ __forceinline__ f32x2 rcp_2(const f32x2 a) { return (f32x2){__builtin_amdgcn_rcpf(a.x), __builtin_amdgcn_rcpf(a.y)}; }
__device__ __forceinline__ unsigned pk2v(const f32x2 v) { return __builtin_bit_cast(unsigned, __builtin_convertvector(v, bf16x2_t)); }
constexpr float GELU_A = -2.f * LOG2E * 0.7978845608028654f, GELU_B = GELU_A * 0.044715f;
__device__ __forceinline__ f32x2 gelu_2(const f32x2 u) { const f32x2 e = exp2_2(u * (u * u * GELU_B + GELU_A)); return u * rcp_2(e + 1.f); }
__device__ __forceinline__ f32x2 sigmoid_2(const f32x2 x, const float nsc) { return rcp_2(exp2_2(x * nsc) + 1.f); }
__device__ __forceinline__ f32x2 gelu_silu_2(const f32x2 u, const f32x2 g) { const f32x2 ea = exp2_2(u * (u * u * GELU_B + GELU_A)), eb = exp2_2(g * (-LOG2E)); return (u * g) * rcp_2((ea + 1.f) * (eb + 1.f)); }
__device__ __forceinline__ f32x4 cat2(const f32x2 a, const f32x2 b) { return __builtin_shufflevector(a, b, 0, 1, 2, 3); }
__device__ __forceinline__ f32x2 rsig_2(const f32x2 x) { const f32x2 e = exp2_2(x * (-LOG2E)) + 1.f; return (f32x2){fminf(e.x, 1e30f), fminf(e.y, 1e30f)}; }

struct EpiA {
    static constexpr bool SPLIT = false, PRELOAD = false, FP8 = true, GATED = false;
    bf16_t* R; const __attribute__((address_space(3))) float* gl;
    typedef int i32x2 __attribute__((ext_vector_type(2)));
    static __device__ __forceinline__ i32x2 f8x8(const f32x4 a, const f32x4 b) {
        int w0 = __builtin_amdgcn_cvt_pk_fp8_f32(a[0], a[1], __float_as_int(a[0]), false); w0 = __builtin_amdgcn_cvt_pk_fp8_f32(a[2], a[3], w0, true);
        int w1 = __builtin_amdgcn_cvt_pk_fp8_f32(b[0], b[1], __float_as_int(b[0]), false); w1 = __builtin_amdgcn_cvt_pk_fp8_f32(b[2], b[3], w1, true);
        return (i32x2){w0, w1};
    }
    __device__ __forceinline__ void operator()(AccRef acc, const pg8::Unit& u, int wr, int wc, int fr, int fq) const {
        const int pn = u.pn, row0 = u.pm * 256 + wr * 64 + fr;
        if (pn < 18) {
            const int seg = pn >> 1, p = seg / 3, which = seg - 3 * p;
            if (which == 2) {
                const int dl = p == 0 ? 0 : (p == 1 ? 2 : 4);
#pragma unroll
                for (int ai = 0; ai < 2; ++ai)
#pragma unroll
                    for (int m = 0; m < 4; ++m) {
                        const int row = row0 + ai * 128 + m * 16, t = row & (SEQ - 1), odd = (t >> dl) & 1;
                        unsigned char* bp = (unsigned char*)(R + (size_t)(row - (odd << dl)) * LDR + pn * 256 + wc * 64) + 64 * odd + 8 * fq;
#pragma unroll
                        for (int bj = 0; bj < 2; ++bj) *(i32x2*)(bp + 32 * bj) = f8x8(acc[ai][bj][m][0], acc[ai][bj][m][1]);
                    }
            } else {
                const float sc = which == 0 ? QSCALE : 1.f; const int kslot = which == 1 ? 2 : 0;
                f32x4 gv[2][2];
#pragma unroll
                for (int bj = 0; bj < 2; ++bj)
#pragma unroll
                    for (int n = 0; n < 2; ++n) gv[bj][n] = *(const __attribute__((address_space(3))) f32x4*)(gl + p * 64 + 32 * bj + 8 * fq + 4 * n) * *(const __attribute__((address_space(3))) f32x4*)(gl + 192 + p * 64 + 32 * bj + 8 * fq + 4 * n);
#pragma unroll
                for (int ai = 0; ai < 2; ++ai)
#pragma unroll
                    for (int m = 0; m < 4; ++m) {
                        const int row = row0 + ai * 128 + m * 16;
                        f32x4 s4 = acc[ai][0][m][0] * acc[ai][0][m][0]; s4 = acc[ai][0][m][1] * acc[ai][0][m][1] + s4; s4 = acc[ai][1][m][0] * acc[ai][1][m][0] + s4; s4 = acc[ai][1][m][1] * acc[ai][1][m][1] + s4;
                        const float ss = sum_fq((s4[0] + s4[1]) + (s4[2] + s4[3]));
                        const float rs = sc * __builtin_amdgcn_rsqf(ss * (1.f / 64.f) + EPS);
                        unsigned char* bp = (unsigned char*)(R + (size_t)row * LDR + (pn - kslot) * 256 + wc * 64) + 32 * kslot + 8 * fq;
                        if (which == 0) {
#pragma unroll
                            for (int bj = 0; bj < 2; ++bj) *(i32x2*)(bp + 32 * bj) = f8x8(acc[ai][bj][m][0] * rs, acc[ai][bj][m][1] * rs);
                        } else {
#pragma unroll
                            for (int bj = 0; bj < 2; ++bj) *(i32x2*)(bp + 32 * bj) = f8x8(acc[ai][bj][m][0] * rs * gv[bj][0], acc[ai][bj][m][1] * rs * gv[bj][1]);
                        }
                    }
            }
        } else if (pn < 20) {
#pragma unroll
            for (int ai = 0; ai < 2; ++ai)
#pragma unroll
                for (int m = 0; m < 4; ++m) {
                    bf16_t* rowp = R + (size_t)(row0 + ai * 128 + m * 16) * LDR + pn * 256 + wc * 64 + 8 * fq;
#pragma unroll
                    for (int bj = 0; bj < 2; ++bj) { const f32x4 x0 = acc[ai][bj][m][0], x1 = acc[ai][bj][m][1];
                        *(u32x4*)(rowp + 32 * bj) = pack8(x0 * cat2(sigmoid_2(lo2(x0), -LOG2E), sigmoid_2(hi2(x0), -LOG2E)), x1 * cat2(sigmoid_2(lo2(x1), -LOG2E), sigmoid_2(hi2(x1), -LOG2E))); }
                }
        } else {
#pragma unroll
            for (int ai = 0; ai < 2; ++ai)
#pragma unroll
                for (int m = 0; m < 4; ++m) {
                    bf16_t* rowp = R + (size_t)(row0 + ai * 128 + m * 16) * LDR + sb_col(pn - 20) + wc * 64 + 8 * fq;
#pragma unroll
                    for (int bj = 0; bj < 2; ++bj) { const f32x4 x0 = acc[ai][bj][m][0], x1 = acc[ai][bj][m][1];
                        *(u32x4*)(rowp + 32 * bj) = pack8(cat2(rsig_2(lo2(x0)), rsig_2(hi2(x0))), cat2(rsig_2(lo2(x1)), rsig_2(hi2(x1)))); }
                }
        }
    }
};
struct EpiB {
    static constexpr bool SPLIT = false, PRELOAD = false, FP8 = false, GATED = true;
    bf16_t* R; float* stats;
    unsigned* topgen; volatile __attribute__((address_space(3))) unsigned* st;
    __device__ __forceinline__ void gate() const {
        if (__builtin_amdgcn_readfirstlane(threadIdx.x >> 6) == 0) { const unsigned gen = st[2]; unsigned sp = 0u; while (__hip_atomic_load(topgen, __ATOMIC_RELAXED, __HIP_MEMORY_SCOPE_AGENT) == gen) { __builtin_amdgcn_s_sleep(1); if (++sp > (1u << 22)) break; } }
        __builtin_amdgcn_s_barrier();
    }
    __device__ __forceinline__ void operator()(AccRef acc, const pg8::Unit& u, int wr, int wc, int fr, int fq) const {
        const int pn = u.pn, row0 = u.pm * 256 + wr * 64 + fr;
        if (pn < 4) {
#pragma unroll
            for (int ai = 0; ai < 2; ++ai)
#pragma unroll
                for (int m = 0; m < 4; ++m) {
                    const int row = row0 + ai * 128 + m * 16;
                    bf16_t* rowp = R + (size_t)row * LDR + RC_V + pn * 256 + wc * 64 + 8 * fq;
                    f32x4 v[2][2];
#pragma unroll
                    for (int bj = 0; bj < 2; ++bj)
#pragma unroll
                        for (int n = 0; n < 2; ++n) { const f32x4 a = acc[ai][bj][m][n]; v[bj][n] = cat2(gelu_2(lo2(a)), gelu_2(hi2(a))); }
                    const f32x4 s4 = (v[0][0] + v[0][1]) + (v[1][0] + v[1][1]);
                    f32x4 q4 = v[0][0] * v[0][0]; q4 = v[0][1] * v[0][1] + q4; q4 = v[1][0] * v[1][0] + q4; q4 = v[1][1] * v[1][1] + q4;
                    float sm = (s4[0] + s4[1]) + (s4[2] + s4[3]), q = (q4[0] + q4[1]) + (q4[2] + q4[3]);
                    sm = sum_fq(sm); q = sum_fq(q);
                    if (fq == 0) *(f32x2*)(stats + ((size_t)row * 16 + pn * 4 + wc) * 2) = (f32x2){sm, q};
#pragma unroll
                    for (int bj = 0; bj < 2; ++bj) *(u32x4*)(rowp + 32 * bj) = pack8(v[bj][0], v[bj][1]);
                }
        } else if (pn < 12) {
#pragma unroll
            for (int ai = 0; ai < 2; ++ai)
#pragma unroll
                for (int m = 0; m < 4; ++m) {
                    const int row = row0 + ai * 128 + m * 16;
                    const f32x4 u0 = acc[ai][0][m][0], u1 = acc[ai][0][m][1], g0 = acc[ai][1][m][0], g1 = acc[ai][1][m][1];
                    u32x4 w; w.x = pk2v(gelu_silu_2(lo2(u0), lo2(g0))); w.y = pk2v(gelu_silu_2(hi2(u0), hi2(g0))); w.z = pk2v(gelu_silu_2(lo2(u1), lo2(g1))); w.w = pk2v(gelu_silu_2(hi2(u1), hi2(g1)));
                    *(u32x4*)(R + (size_t)row * LDR + RC_U + (pn - 4) * 128 + wc * 32 + 8 * fq) = w;
                }
        } else {
#pragma unroll
            for (int ai = 0; ai < 2; ++ai)
#pragma unroll
                for (int m = 0; m < 4; ++m) {
                    bf16_t* rowp = R + (size_t)(row0 + ai * 128 + m * 16) * LDR + sa_col(pn - 12) + wc * 64 + 8 * fq;
#pragma unroll
                    for (int bj = 0; bj < 2; ++bj) { const f32x4 x0 = acc[ai][bj][m][0], x1 = acc[ai][bj][m][1];
                        *(u32x4*)(rowp + 32 * bj) = pack8(cat2(sigmoid_2(lo2(x0), -LOG2E), sigmoid_2(hi2(x0), -LOG2E)), cat2(sigmoid_2(lo2(x1), -LOG2E), sigmoid_2(hi2(x1), -LOG2E))); }
                }
        }
    }
};
struct EpiM {
    static constexpr bool SPLIT = true, PRELOAD = false, FP8 = false, GATED = false;
    bf16_t* R;
    __device__ __forceinline__ void mid(f32x4 (&acc)[2][2][4][2], const pg8::Unit& u, int wr, int wc, int fr, int fq) const {
        const int row0 = u.pm * 256 + wr * 64 + fr;
#pragma unroll
        for (int ai = 0; ai < 2; ++ai) {
            u32x4 ga[4][2], gb[4][2];
#pragma unroll
            for (int m = 0; m < 4; ++m) {
                const bf16_t* sp = R + (size_t)(row0 + ai * 128 + m * 16) * LDR + wc * 64 + 8 * fq;
#pragma unroll
                for (int bj = 0; bj < 2; ++bj) { ga[m][bj] = *(const u32x4*)(sp + sa_col(u.pn) + 32 * bj); gb[m][bj] = *(const u32x4*)(sp + sb_col(u.pn) + 32 * bj); }
            }
#pragma unroll
            for (int m = 0; m < 4; ++m)
#pragma unroll
                for (int bj = 0; bj < 2; ++bj) {
                    const u32x4 a = ga[m][bj], b = gb[m][bj];
                    const f32x4 a0 = (f32x4){bflo(a.x), bfhi(a.x), bflo(a.y), bfhi(a.y)}, a1 = (f32x4){bflo(a.z), bfhi(a.z), bflo(a.w), bfhi(a.w)};
                    const f32x4 b0 = (f32x4){bflo(b.x), bfhi(b.x), bflo(b.y), bfhi(b.y)}, b1 = (f32x4){bflo(b.z), bfhi(b.z), bflo(b.w), bfhi(b.w)};
                    acc[ai][bj][m][0] = acc[ai][bj][m][0] * (a0 * b0); acc[ai][bj][m][1] = acc[ai][bj][m][1] * (a1 * b1);
                }
        }
    }
    __device__ __forceinline__ void operator()(AccRef acc, const pg8::Unit& u, int wr, int wc, int fr, int fq) const {
        const int row0 = u.pm * 256 + wr * 64 + fr;
        u32x4 gb[2][4][2];
#pragma unroll
        for (int ai = 0; ai < 2; ++ai)
#pragma unroll
            for (int m = 0; m < 4; ++m) {
                const bf16_t* sp = R + (size_t)(row0 + ai * 128 + m * 16) * LDR + sb_col(u.pn) + wc * 64 + 8 * fq;
#pragma unroll
                for (int bj = 0; bj < 2; ++bj) gb[ai][m][bj] = *(const u32x4*)(sp + 32 * bj);
            }
#pragma unroll
        for (int ai = 0; ai < 2; ++ai)
#pragma unroll
            for (int m = 0; m < 4; ++m) {
                bf16_t* rp = R + (size_t)(row0 + ai * 128 + m * 16) * LDR + u.pn * 256 + wc * 64 + 8 * fq;
#pragma unroll
                for (int bj = 0; bj < 2; ++bj) {
                    const u32x4 b = gb[ai][m][bj];
                    f32x4 s0, s1;
                    s0[0] = __builtin_amdgcn_rcpf(bflo(b.x)); s0[1] = __builtin_amdgcn_rcpf(bfhi(b.x)); s0[2] = __builtin_amdgcn_rcpf(bflo(b.y)); s0[3] = __builtin_amdgcn_rcpf(bfhi(b.y));
                    s1[0] = __builtin_amdgcn_rcpf(bflo(b.z)); s1[1] = __builtin_amdgcn_rcpf(bfhi(b.z)); s1[2] = __builtin_amdgcn_rcpf(bflo(b.w)); s1[3] = __builtin_amdgcn_rcpf(bfhi(b.w));
                    *(u32x4*)(rp + RC_V + 32 * bj) = pack8(s0 * acc[ai][bj][m][0], s1 * acc[ai][bj][m][1]);
                }
            }
    }
};
struct EpiOut {
    static constexpr bool SPLIT = false, PRELOAD = true, FP8 = false, GATED = false;
    const float* x; float* out;
    __device__ __forceinline__ void preload(f32x4 (&acc)[2][2][4][2], const pg8::Unit& u, int wr, int wc, int fr, int fq) const {
#pragma unroll
        for (int ai = 0; ai < 2; ++ai)
#pragma unroll
            for (int m = 0; m < 4; ++m) {
                const int row = u.pm * 256 + ai * 128 + wr * 64 + m * 16 + fr;
                const size_t o = (size_t)row * D + u.pn * 256 + wc * 64 + 8 * fq;
#pragma unroll
                for (int bj = 0; bj < 2; ++bj) { acc[ai][bj][m][0] = __builtin_nontemporal_load((const f32x4*)(x + o + 32 * bj)); acc[ai][bj][m][1] = __builtin_nontemporal_load((const f32x4*)(x + o + 32 * bj + 4)); }
            }
    }
    __device__ __forceinline__ void operator()(AccRef acc, const pg8::Unit& u, int wr, int wc, int fr, int fq) const {
#pragma unroll
        for (int ai = 0; ai < 2; ++ai)
#pragma unroll
            for (int m = 0; m < 4; ++m) {
                const int row = u.pm * 256 + ai * 128 + wr * 64 + m * 16 + fr;
                const size_t o = (size_t)row * D + u.pn * 256 + wc * 64 + 8 * fq;
#pragma unroll
                for (int bj = 0; bj < 2; ++bj) { *(f32x4*)(out + o + 32 * bj) = acc[ai][bj][m][0]; *(f32x4*)(out + o + 32 * bj + 4) = acc[ai][bj][m][1]; }
            }
    }
};

#define GAS __attribute__((address_space(1)))
#define LAS __attribute__((address_space(3)))
typedef unsigned short bf16;
typedef unsigned v4u __attribute__((ext_vector_type(4)));
typedef float f32x4 __attribute__((ext_vector_type(4)));
typedef short bf16x8 __attribute__((ext_vector_type(8)));
typedef GAS unsigned gu32;
typedef GAS unsigned long long gu64;
#define RLX_AGENT __ATOMIC_RELAXED, __HIP_MEMORY_SCOPE_AGENT
#define LDS_WAIT() asm volatile("s_waitcnt lgkmcnt(0)" ::: "memory")
#define VM_WAIT() asm volatile("s_waitcnt vmcnt(0)" ::: "memory")
__device__ __forceinline__ unsigned long long rt() { return __builtin_amdgcn_s_memrealtime(); }

#define XB_TMO      128
#define XB_XCNT(j)  (256  + 64 * (j))
#define XB_XSUB(j)  (1280 + 64 * (j))
#define XB_XGEN(j)  (2304 + 64 * (j))
#define XB_TOP      3328
#define XB_TOPGEN   3392
#define XCD_BAR_WORDS 3456
#define XB_SPIN_CAP (1u << 18)

__device__ __forceinline__ unsigned xb_ld(unsigned* p)              { return __hip_atomic_load(p, __ATOMIC_RELAXED, __HIP_MEMORY_SCOPE_AGENT); }
__device__ __forceinline__ unsigned xb_add(unsigned* p, unsigned v) { return __hip_atomic_fetch_add(p, v, __ATOMIC_RELAXED, __HIP_MEMORY_SCOPE_AGENT); }
__device__ __forceinline__ unsigned xb_xcc_id() { return (unsigned)__builtin_amdgcn_s_getreg((3 << 11) | 20) & 0xFu; }
#define XB_SPIN(cond, bar) do { unsigned _sp = 0; while (cond) { __builtin_amdgcn_s_sleep(1); \
    if ((++_sp & 255u) == 0u) { if (xb_ld(&(bar)[XB_TMO])) break; if (_sp > XB_SPIN_CAP) { atomicAdd(&(bar)[XB_TMO], 1u); break; } } } } while (0)

struct XcdBarrier {
    unsigned* bar; unsigned x;
    volatile LAS unsigned* st;
};

__device__ __forceinline__ XcdBarrier xcd_barrier_post(unsigned* bar, volatile LAS unsigned* st) {
    XcdBarrier b; b.bar = bar; b.x = xb_xcc_id(); b.st = st;
    if (threadIdx.x == 0) (void)xb_add(&bar[XB_XCNT(b.x)], 1u);
    return b;
}
__device__ __forceinline__ void xcd_barrier_complete(unsigned* bar, unsigned x, unsigned& nloc, unsigned& nx) {
    const unsigned G = gridDim.x * gridDim.y * gridDim.z;
    unsigned sum, cnt, mine, sp = 0u;
    for (;;) {
        sum = 0u; cnt = 0u; mine = 0u;
#pragma unroll
        for (unsigned j = 0; j < 16; ++j) { const unsigned c = xb_ld(&bar[XB_XCNT(j)]); sum += c; cnt += (c > 0u) ? 1u : 0u; mine = (j == x) ? c : mine; }
        if (sum == G) break;
        __builtin_amdgcn_s_sleep(1);
        if ((++sp & 255u) == 0u) { if (xb_ld(&bar[XB_TMO])) break; if (sp > XB_SPIN_CAP) { atomicAdd(&bar[XB_TMO], 1u); break; } }
    }
    nloc = mine > 0u ? mine : 1u; nx = cnt > 0u ? cnt : 1u;
}

__device__ __forceinline__ void xcd_barrier_arrive() {
    asm volatile("s_waitcnt vmcnt(0)" ::: "memory");
    __syncthreads();
}
__device__ __forceinline__ void xcd_barrier_wait(const XcdBarrier& b) {
    if (threadIdx.x == 0) {
        unsigned* bar = b.bar;
        __builtin_amdgcn_s_waitcnt(0);
        unsigned nloc = b.st[0], nx = b.st[1];
        if (nloc == 0u) { xcd_barrier_complete(bar, b.x, nloc, nx); b.st[0] = nloc; b.st[1] = nx; }
        const unsigned old = xb_add(&bar[XB_XSUB(b.x)], 1u);
        const unsigned gen = old / nloc;
        if (old + 1u == (gen + 1u) * nloc) {
            __builtin_amdgcn_fence(__ATOMIC_RELEASE, "agent");
            asm volatile("s_waitcnt vmcnt(0)" ::: "memory");
            const unsigned og = xb_add(&bar[XB_TOP], 1u);
            const unsigned tg = og / nx;
            if (og + 1u == (tg + 1u) * nx) xb_add(&bar[XB_TOPGEN], 1u);
        }
        XB_SPIN(xb_ld(&bar[XB_TOPGEN]) == gen, bar);
        __builtin_amdgcn_fence(__ATOMIC_ACQUIRE, "agent");
        asm volatile("s_waitcnt vmcnt(0)" ::: "memory");
    }
    __syncthreads();
}
__device__ __forceinline__ void xcd_barrier(const XcdBarrier& b) { xcd_barrier_arrive(); xcd_barrier_wait(b); }
__device__ __forceinline__ void xcd_barrier_signal(const XcdBarrier& b) {
    if (threadIdx.x == 0) {
        unsigned* bar = b.bar;
        __builtin_amdgcn_s_waitcnt(0);
        unsigned nloc = b.st[0], nx = b.st[1];
        if (nloc == 0u) { xcd_barrier_complete(bar, b.x, nloc, nx); b.st[0] = nloc; b.st[1] = nx; }
        const unsigned old = xb_add(&bar[XB_XSUB(b.x)], 1u);
        const unsigned gen = old / nloc;
        if (old + 1u == (gen + 1u) * nloc) {
            __builtin_amdgcn_fence(__ATOMIC_RELEASE, "agent");
            asm volatile("s_waitcnt vmcnt(0)" ::: "memory");
            const unsigned og = xb_add(&bar[XB_TOP], 1u);
            const unsigned tg = og / nx;
            if (og + 1u == (tg + 1u) * nx) xb_add(&bar[XB_TOPGEN], 1u);
        }
        b.st[2] = gen;
    }
}
__device__ __forceinline__ void xcd_barrier_finish(const XcdBarrier& b) {
    if (threadIdx.x == 0) {
        unsigned* bar = b.bar; const unsigned gen = b.st[2];
        XB_SPIN(xb_ld(&bar[XB_TOPGEN]) == gen, bar);
        __builtin_amdgcn_fence(__ATOMIC_ACQUIRE, "agent");
        asm volatile("s_waitcnt vmcnt(0)" ::: "memory");
    }
    __syncthreads();
}

__device__ __forceinline__ void cl_barrier_signal(unsigned* ctlw, int pm) {
    if (threadIdx.x == 0) {
        __builtin_amdgcn_s_waitcnt(0);
        const unsigned* xt = ctlw + 3072; const int b0 = (pm >> 3) + 8 * (pm & 7);
        const unsigned x0 = xb_ld((unsigned*)xt + b0), x1 = xb_ld((unsigned*)xt + b0 + 64), x2 = xb_ld((unsigned*)xt + b0 + 128), x3 = xb_ld((unsigned*)xt + b0 + 192);
        if (!(x0 == x1 && x1 == x2 && x2 == x3 && x0 != 0u)) { __builtin_amdgcn_fence(__ATOMIC_RELEASE, "agent"); asm volatile("s_waitcnt vmcnt(0)" ::: "memory"); }
        (void)xb_add(ctlw + 2048 + 16 * pm, 1u);
    }
}
__device__ __forceinline__ void cl_barrier_wait(unsigned* ctlw, unsigned* bar, int pm, unsigned target, int slot = 0, int pm2 = -1) {
    if (threadIdx.x == 0) {
        __builtin_amdgcn_s_waitcnt(0);
        const unsigned* xt = ctlw + 3072; const int b0 = (pm >> 3) + 8 * (pm & 7);
        const unsigned x0 = xb_ld((unsigned*)xt + b0), x1 = xb_ld((unsigned*)xt + b0 + 64), x2 = xb_ld((unsigned*)xt + b0 + 128), x3 = xb_ld((unsigned*)xt + b0 + 192);
        if (!(x0 == x1 && x1 == x2 && x2 == x3 && x0 != 0u)) { __builtin_amdgcn_fence(__ATOMIC_RELEASE, "agent"); asm volatile("s_waitcnt vmcnt(0)" ::: "memory"); }
        unsigned* cw = ctlw + 2048 + 16 * pm + slot;
        (void)xb_add(cw, 1u);
        XB_SPIN(xb_ld(cw) < target, bar);
        if (pm2 >= 0) { unsigned* cw2 = ctlw + 2048 + 16 * pm2 + slot; XB_SPIN(xb_ld(cw2) < target, bar); }
        __builtin_amdgcn_fence(__ATOMIC_ACQUIRE, "agent");
        asm volatile("s_waitcnt vmcnt(0)" ::: "memory");
    }
    __syncthreads();
}

typedef short s16x4 __attribute__((ext_vector_type(4)));
typedef short v4i16_t __attribute__((ext_vector_type(4)));
typedef float f32x16 __attribute__((ext_vector_type(16)));
__device__ __forceinline__ s16x4 vtr(const LAS unsigned char* p) { return __builtin_bit_cast(s16x4, __builtin_amdgcn_ds_read_tr16_b64_v4i16((LAS v4i16_t*)p)); }
__device__ __forceinline__ int crow(int r, int hi) { return (r & 3) + 8 * (r >> 2) + 4 * hi; }
__device__ __forceinline__ bf16x8 pack8s(const f32x16& s, int o) { u32x4 w; w.x = pk2(s[o], s[o + 1]); w.y = pk2(s[o + 2], s[o + 3]); w.z = pk2(s[o + 4], s[o + 5]); w.w = pk2(s[o + 6], s[o + 7]); return __builtin_bit_cast(bf16x8, w); }
constexpr int AT_KP = 72;
constexpr int AT_K_OFF = 0, AT_V_OFF = 384 * AT_KP, AT_VH = 384 * 64;
constexpr int AT_SP = 68, AT_SW = 32 * AT_SP * 4 + 128;

struct AttnGeom { bf16_t* base; int d, res, i0, b, h, p; };
__device__ __forceinline__ AttnGeom attn_geom(int p, int idx, bf16_t* R) {
    AttnGeom g; g.p = p; g.d = p == 0 ? 1 : (p == 1 ? 4 : 16); const int nblk = 16 / g.d;
    const int bh = idx >> 4, rem = idx & 15, blk = rem % nblk; g.res = rem / nblk; g.b = bh >> 3; g.h = bh & 7; g.i0 = blk * 256;
    g.base = R + (size_t)g.b * SEQ * LDR + p * 1536 + g.h * 64;
    return g;
}
typedef long fp8x8;
__device__ __forceinline__ void attn_load(const AttnGeom& g, int tid, u32x4 (&kr)[3], u32x4 (&vr)[3], fp8x8 (&qr)[4]) {
    const int lane = tid & 63, wave = tid >> 6, r32 = lane & 31, hi = lane >> 5;
#pragma unroll
    for (int k = 0; k < 3; ++k) {
        const int c = tid + 512 * k, rho = c >> 2, ch = c & 3, pos = g.i0 - 128 + rho;
        vr[k] = (u32x4){0u, 0u, 0u, 0u};
        if (pos >= 0) vr[k] = *(const u32x4*)((const unsigned char*)(g.base + (size_t)((pos & ~1) * g.d + g.res) * LDR + 1024) + 64 * (pos & 1) + ch * 16);
    }
#pragma unroll
    for (int k = 0; k < 3; ++k) {
        const int c = tid + 512 * k, rho = c >> 2, ch = c & 3, pos = g.i0 - 128 + rho;
        kr[k] = (u32x4){0u, 0u, 0u, 0u};
        if (pos >= 0) kr[k] = *(const u32x4*)((const unsigned char*)(g.base + (size_t)(pos * g.d + g.res) * LDR) + 64 + ch * 16);
    }
    const unsigned char* qrow = (const unsigned char*)(g.base + (size_t)((g.i0 + 32 * wave + r32) * g.d + g.res) * LDR);
#pragma unroll
    for (int d0 = 0; d0 < 4; ++d0) qr[d0] = *(const fp8x8*)(qrow + 16 * d0 + 8 * hi);
}
__device__ __forceinline__ void attn_stage(const u32x4 (&kr)[3], const u32x4 (&vr)[3], LAS unsigned char* lds, int tid) {
    typedef unsigned u32x2 __attribute__((ext_vector_type(2)));
#pragma unroll
    for (int k = 0; k < 3; ++k) {
        const int c = tid + 512 * k, rho = c >> 2, ch = c & 3;
        *(LAS u32x2*)(lds + AT_K_OFF + rho * AT_KP + ch * 16) = (u32x2){kr[k].x, kr[k].y};
        *(LAS u32x2*)(lds + AT_K_OFF + rho * AT_KP + ch * 16 + 8) = (u32x2){kr[k].z, kr[k].w};
    }
#pragma unroll
    for (int k = 0; k < 3; ++k) {
        const int c = tid + 512 * k, rho = c >> 2, ch = c & 3;
        const u32x4 w = vr[k];
        u32x4 lo, hi2;
        lo.x = pk2(__builtin_amdgcn_cvt_f32_fp8(w.x, 0), __builtin_amdgcn_cvt_f32_fp8(w.x, 1)); lo.y = pk2(__builtin_amdgcn_cvt_f32_fp8(w.x, 2), __builtin_amdgcn_cvt_f32_fp8(w.x, 3));
        lo.z = pk2(__builtin_amdgcn_cvt_f32_fp8(w.y, 0), __builtin_amdgcn_cvt_f32_fp8(w.y, 1)); lo.w = pk2(__builtin_amdgcn_cvt_f32_fp8(w.y, 2), __builtin_amdgcn_cvt_f32_fp8(w.y, 3));
        hi2.x = pk2(__builtin_amdgcn_cvt_f32_fp8(w.z, 0), __builtin_amdgcn_cvt_f32_fp8(w.z, 1)); hi2.y = pk2(__builtin_amdgcn_cvt_f32_fp8(w.z, 2), __builtin_amdgcn_cvt_f32_fp8(w.z, 3));
        hi2.z = pk2(__builtin_amdgcn_cvt_f32_fp8(w.w, 0), __builtin_amdgcn_cvt_f32_fp8(w.w, 1)); hi2.w = pk2(__builtin_amdgcn_cvt_f32_fp8(w.w, 2), __builtin_amdgcn_cvt_f32_fp8(w.w, 3));
        LAS unsigned char* dst = lds + AT_V_OFF + (ch >> 1) * AT_VH + rho * 64 + (ch & 1) * 32;
        *(LAS u32x4*)dst = lo; *(LAS u32x4*)(dst + 16) = hi2;
    }
}
template <bool COMBINE, bool LATE = false> __device__ __forceinline__ void attn_compute(const AttnGeom& g, const fp8x8 (&qr)[4], bf16_t* R, float* DEN, float cneg, LAS unsigned char* lds, int tid, unsigned* gate_tg = nullptr, volatile LAS unsigned* gate_st = nullptr) {
    const int lane = tid & 63, wave = __builtin_amdgcn_readfirstlane(tid >> 6), r32 = lane & 31, hi = lane >> 5;
    const int i0 = g.i0, d = g.d, res = g.res, b = g.b, h = g.h, p = g.p; bf16_t* base = g.base;
    f32x16 o0, o1, cinit; f32x2 den2 = {0.f, 0.f};
#pragma unroll
    for (int r = 0; r < 16; ++r) { o0[r] = 0.f; o1[r] = 0.f; cinit[r] = cneg; }
    const int q4 = (lane & 15) >> 2, pp = lane & 3, cb = (lane >> 4) & 1;
    typedef unsigned u32x2_t __attribute__((ext_vector_type(2)));
    u32x2_t pn1[4], pn2[4]; u32x4 pgb[4]; float pd1[4], pd2[4];
#define ATT_COMBINE_LOADS() do { _Pragma("unroll") \
        for (int i = 0; i < 4; ++i) { \
            const int row = i * 8 + (lane >> 3), c = lane & 7; \
            const size_t gt = (size_t)b * SEQ + (i0 + 32 * wave + row) * d + res; \
            const bf16_t* rp = R + gt * LDR + h * 64 + c * 8; \
            const unsigned char* np = (const unsigned char*)(R + gt * LDR + 1536 + 512 + h * 64) + c * 8;             \
            pn1[i] = *(const u32x2_t*)np; pn2[i] = *(const u32x2_t*)(np + 64); pgb[i] = *(const u32x4*)(rp + RC_BGATE); \
            pd1[i] = DEN[gt * NH + h]; pd2[i] = DEN[((size_t)M + gt) * NH + h]; \
        } } while (0)
    if constexpr (COMBINE && !LATE) ATT_COMBINE_LOADS();
#define ATT_VALID(kk) (!(i0 == 0 && wave + (kk) < 4))
#define ATT_QK(kk, S) do { if (ATT_VALID(kk)) { \
        const LAS unsigned char* kp = lds + AT_K_OFF + (32 * (wave + (kk)) + r32) * AT_KP + 8 * hi; \
        const fp8x8 k0_ = *(const LAS fp8x8*)(kp), k1_ = *(const LAS fp8x8*)(kp + 16), k2_ = *(const LAS fp8x8*)(kp + 32), k3_ = *(const LAS fp8x8*)(kp + 48); \
        S = __builtin_amdgcn_mfma_f32_32x32x16_fp8_fp8(k0_, qr[0], cinit, 0, 0, 0); S = __builtin_amdgcn_mfma_f32_32x32x16_fp8_fp8(k1_, qr[1], S, 0, 0, 0); \
        S = __builtin_amdgcn_mfma_f32_32x32x16_fp8_fp8(k2_, qr[2], S, 0, 0, 0); S = __builtin_amdgcn_mfma_f32_32x32x16_fp8_fp8(k3_, qr[3], S, 0, 0, 0); } } while (0)
#define ATT_PV(kk, S) do { if (ATT_VALID(kk)) { \
        const LAS unsigned char* vp = lds + AT_V_OFF + (32 * (wave + (kk)) + 4 * hi + q4) * 64 + cb * 32 + pp * 8; \
        const s16x4 a0_ = vtr(vp), a1_ = vtr(vp + 512), b0_ = vtr(vp + AT_VH), b1_ = vtr(vp + AT_VH + 512); \
        const s16x4 a2_ = vtr(vp + 1024), a3_ = vtr(vp + 1536), b2_ = vtr(vp + AT_VH + 1024), b3_ = vtr(vp + AT_VH + 1536); \
        _Pragma("unroll") for (int r = 0; r < 16; ++r) { \
            float e = __builtin_amdgcn_exp2f(S[r]); \
            if ((kk) == 0) e = (crow(r, hi) >= r32) ? e : 0.f;              \
            if ((kk) == 4) e = (crow(r, hi) <= r32) ? e : 0.f;              \
            S[r] = e; } \
        _Pragma("unroll") for (int r = 0; r < 16; r += 2) den2 += (f32x2){S[r], S[r + 1]}; \
        const bf16x8 pa0 = pack8s(S, 0), pa1 = pack8s(S, 8); \
        o0 = __builtin_amdgcn_mfma_f32_32x32x16_bf16(pa0, (bf16x8){a0_[0], a0_[1], a0_[2], a0_[3], a1_[0], a1_[1], a1_[2], a1_[3]}, o0, 0, 0, 0); \
        o1 = __builtin_amdgcn_mfma_f32_32x32x16_bf16(pa0, (bf16x8){b0_[0], b0_[1], b0_[2], b0_[3], b1_[0], b1_[1], b1_[2], b1_[3]}, o1, 0, 0, 0); \
        o0 = __builtin_amdgcn_mfma_f32_32x32x16_bf16(pa1, (bf16x8){a2_[0], a2_[1], a2_[2], a2_[3], a3_[0], a3_[1], a3_[2], a3_[3]}, o0, 0, 0, 0); \
        o1 = __builtin_amdgcn_mfma_f32_32x32x16_bf16(pa1, (bf16x8){b2_[0], b2_[1], b2_[2], b2_[3], b3_[0], b3_[1], b3_[2], b3_[3]}, o1, 0, 0, 0); } } while (0)
    {
        f32x16 sA = cinit, sB = cinit;
        ATT_QK(0, sA); ATT_QK(1, sB);
        ATT_PV(0, sA); ATT_QK(2, sA);
        ATT_PV(1, sB); ATT_QK(3, sB);
        ATT_PV(2, sA); ATT_QK(4, sA);
        ATT_PV(3, sB);
        ATT_PV(4, sA);
    }
#undef ATT_VALID
#undef ATT_QK
#undef ATT_PV
    float den = den2.x + den2.y; den += __shfl_xor(den, 32);
    if constexpr (COMBINE && LATE) {
        if (tid == 0) { const unsigned gen = gate_st[2]; unsigned sp = 0u; while (__hip_atomic_load(gate_tg, __ATOMIC_RELAXED, __HIP_MEMORY_SCOPE_AGENT) == gen) { __builtin_amdgcn_s_sleep(1); if (++sp > (1u << 22)) break; }
            __builtin_amdgcn_fence(__ATOMIC_ACQUIRE, "agent"); asm volatile("s_waitcnt vmcnt(0)" ::: "memory"); }
    }
    __syncthreads();
    if constexpr (COMBINE && LATE) ATT_COMBINE_LOADS();
    LAS float* stg = (LAS float*)(lds + wave * AT_SW); LAS float* dstg = stg + 32 * AT_SP;
#pragma unroll
    for (int r = 0; r < 16; ++r) { const int q = crow(r, hi); stg[q * AT_SP + r32] = o0[r]; stg[q * AT_SP + 32 + r32] = o1[r]; }
    if (hi == 0) dstg[r32] = den;
    LDS_WAIT(); asm volatile("" ::: "memory");
#pragma unroll
    for (int i = 0; i < 4; ++i) {
        const int row = i * 8 + (lane >> 3), c = lane & 7;
        const f32x4 a0 = *(const LAS f32x4*)(stg + row * AT_SP + c * 8), a1 = *(const LAS f32x4*)(stg + row * AT_SP + c * 8 + 4);
        const int tok = (i0 + 32 * wave + row) * d + res;
        const float dn = dstg[row];
        if (!COMBINE) {
            {
                const float rd = __builtin_amdgcn_rcpf(dn); const f32x4 n0 = a0 * rd, n1 = a1 * rd;
                int w0 = __builtin_amdgcn_cvt_pk_fp8_f32(n0[0], n0[1], 0, false); w0 = __builtin_amdgcn_cvt_pk_fp8_f32(n0[2], n0[3], w0, true);
                int w1 = __builtin_amdgcn_cvt_pk_fp8_f32(n1[0], n1[1], 0, false); w1 = __builtin_amdgcn_cvt_pk_fp8_f32(n1[2], n1[3], w1, true);
                typedef int i32x2 __attribute__((ext_vector_type(2)));
                *(i32x2*)((unsigned char*)(R + ((size_t)b * SEQ + tok) * LDR + 1536 + 512 + h * 64) + 64 * (p - 1) + c * 8) = (i32x2){w0, w1};
            }
            if (c == 0) DEN[((size_t)(p - 1) * M + (size_t)b * SEQ + tok) * NH + h] = dn;
        } else {
            bf16_t* rp = R + ((size_t)b * SEQ + tok) * LDR + h * 64 + c * 8;
            const u32x2_t n1 = pn1[i], n2 = pn2[i]; const u32x4 gb = pgb[i];
            const float d1 = pd1[i], d2 = pd2[i], inv = __builtin_amdgcn_rcpf(dn + d1 + d2);
#define O8(w, k) __builtin_amdgcn_cvt_f32_fp8((int)(w), (k))
            f32x4 y0, y1;
            y0[0] = (a0[0] + d1 * O8(n1.x, 0) + d2 * O8(n2.x, 0)) * inv * bflo(gb.x); y0[1] = (a0[1] + d1 * O8(n1.x, 1) + d2 * O8(n2.x, 1)) * inv * bfhi(gb.x);
            y0[2] = (a0[2] + d1 * O8(n1.x, 2) + d2 * O8(n2.x, 2)) * inv * bflo(gb.y); y0[3] = (a0[3] + d1 * O8(n1.x, 3) + d2 * O8(n2.x, 3)) * inv * bfhi(gb.y);
            y1[0] = (a1[0] + d1 * O8(n1.y, 0) + d2 * O8(n2.y, 0)) * inv * bflo(gb.z); y1[1] = (a1[1] + d1 * O8(n1.y, 1) + d2 * O8(n2.y, 1)) * inv * bfhi(gb.z);
            y1[2] = (a1[2] + d1 * O8(n1.y, 2) + d2 * O8(n2.y, 2)) * inv * bflo(gb.w); y1[3] = (a1[3] + d1 * O8(n1.y, 3) + d2 * O8(n2.y, 3)) * inv * bfhi(gb.w);
#undef O8
            *(u32x4*)(rp + RC_YB) = pack8(y0, y1);
        }
    }
    __syncthreads();
#undef ATT_COMBINE_LOADS
}
template <bool COMBINE> __device__ __forceinline__ void attn_phase(int first, int stride, int n, bf16_t* R, float* DEN, float cneg, LAS unsigned char* lds, int tid, unsigned* gate_tg = nullptr, volatile LAS unsigned* gate_st = nullptr) {
    int i = first; if (i >= n) return;
    u32x4 kr[3], vr[3]; fp8x8 qn[4], qr[4];
    AttnGeom g = COMBINE ? attn_geom(0, i, R) : attn_geom(1 + (i >> 9), i & 511, R);
    attn_load(g, tid, kr, vr, qn);
    for (;;) {
        attn_stage(kr, vr, lds, tid);
#pragma unroll
        for (int d0 = 0; d0 < 4; ++d0) qr[d0] = qn[d0];
        __syncthreads();
        const int inext = i + stride; const bool has = inext < n; AttnGeom gn = g;
        if (has) { gn = COMBINE ? attn_geom(0, inext, R) : attn_geom(1 + (inext >> 9), inext & 511, R); attn_load(gn, tid, kr, vr, qn); }
        if (COMBINE && gate_tg != nullptr && i == first) attn_compute<COMBINE, COMBINE>(g, qr, R, DEN, cneg, lds, tid, gate_tg, gate_st);
        else attn_compute<COMBINE>(g, qr, R, DEN, cneg, lds, tid);
        if (!has) break;
        g = gn; i = inext;
    }
}

constexpr int SG_MS_OFF = 0, SG_V_OFF = 1024;
__device__ __forceinline__ void sgu_unit(int item, bf16_t* R, const float* stats, const bf16_t* aws, const float* a_bs, const float* ln_g, const float* ln_b, LAS unsigned char* lds, int tid) {
    const int lane = tid & 63, wave = __builtin_amdgcn_readfirstlane(tid >> 6), r32 = lane & 31, hi = lane >> 5;
    const int g = item % AG, ck = item / AG, tok0 = ck * CH;
    u32x4 pl[2][4];
#pragma unroll
    for (int half = 0; half < 2; ++half)
#pragma unroll
        for (int k = 0; k < 4; ++k) { const int q = tid + 512 * k, il = q >> 5, c = q & 31; pl[half][k] = *(const u32x4*)(R + (size_t)(tok0 + 64 * half + il) * LDR + RC_U + g * AGW + c * 8); }
    LAS f32x2* ms = (LAS f32x2*)(lds + SG_MS_OFF);
    if (tid < CH) { const f32x4* st = (const f32x4*)(stats + (size_t)(tok0 + tid) * 32); float s = 0.f, q = 0.f;
#pragma unroll
        for (int i = 0; i < 8; ++i) { const f32x4 v = st[i]; s += v[0] + v[2]; q += v[1] + v[3]; }
        const float mu = s * (1.f / 1024.f); const float var = fmaxf(q * (1.f / 1024.f) - mu * mu, 0.f);
        ms[tid] = (f32x2){mu, __builtin_amdgcn_rsqf(var + EPS)}; }
    __syncthreads();
    {
        const int c = tid & 31, ch0 = g * AGW + c * 8;
        const f32x4 g0 = *(const f32x4*)(ln_g + ch0), g1 = *(const f32x4*)(ln_g + ch0 + 4), b0 = *(const f32x4*)(ln_b + ch0), b1 = *(const f32x4*)(ln_b + ch0 + 4);
#pragma unroll
        for (int k = 0; k < 8; ++k) {
            const int j = (tid >> 5) + 16 * k;
            const u32x4 raw = *(const u32x4*)(R + (size_t)(tok0 + j) * LDR + RC_V + ch0);
            const f32x2 m = ms[j];
            f32x4 v0 = (f32x4){bflo(raw.x), bfhi(raw.x), bflo(raw.y), bfhi(raw.y)}, v1 = (f32x4){bflo(raw.z), bfhi(raw.z), bflo(raw.w), bfhi(raw.w)};
            v0 = (v0 - m.x) * m.y * g0 + b0; v1 = (v1 - m.x) * m.y * g1 + b1;
            *(LAS u32x4*)(lds + SG_V_OFF + (c >> 2) * 8192 + j * 64 + (c & 3) * 16) = pack8(v0, v1);
        }
    }
    __syncthreads();
    f32x16 acc[4];
#pragma unroll
    for (int a = 0; a < 4; ++a)
#pragma unroll
        for (int r = 0; r < 16; ++r) acc[a][r] = a_bs[g * CH + 32 * a + crow(r, hi)];
    {
        const int q4 = (lane & 15) >> 2, pp = lane & 3, cb = (lane >> 4) & 1;
        const LAS unsigned char* vp = lds + SG_V_OFF + wave * 8192 + (8 * hi + q4) * 64 + cb * 32 + pp * 8;
        const bf16_t* wp = aws + ((size_t)g * CH + r32) * CH + 8 * hi;
#pragma unroll
        for (int s = 0; s < 8; ++s) {
            const s16x4 lo = vtr(vp + s * 1024), hh = vtr(vp + s * 1024 + 256);
            const bf16x8 vf = (bf16x8){lo[0], lo[1], lo[2], lo[3], hh[0], hh[1], hh[2], hh[3]};
#pragma unroll
            for (int a = s >> 1; a < 4; ++a) { const bf16x8 wf = *(const bf16x8*)(wp + (size_t)(32 * a) * CH + 16 * s); acc[a] = __builtin_amdgcn_mfma_f32_32x32x16_bf16(wf, vf, acc[a], 0, 0, 0); }
        }
    }
    __syncthreads();
    LAS float* sl = (LAS float*)(lds + SG_V_OFF);
#pragma unroll
    for (int half = 0; half < 2; ++half) {
#pragma unroll
        for (int a2 = 0; a2 < 2; ++a2)
#pragma unroll
            for (int r = 0; r < 16; ++r) sl[(32 * a2 + crow(r, hi)) * AGW + 32 * wave + r32] = acc[2 * half + a2][r];
        __syncthreads();
#pragma unroll
        for (int k = 0; k < 4; ++k) {
            const int q = tid + 512 * k, il = q >> 5, c = q & 31;
            const f32x4 s0 = *(const LAS f32x4*)(sl + il * AGW + c * 8), s1 = *(const LAS f32x4*)(sl + il * AGW + c * 8 + 4);
            bf16_t* up = R + (size_t)(tok0 + 64 * half + il) * LDR + RC_U + g * AGW + c * 8;
            const u32x4 pp_ = pl[half][k];
            const f32x4 y0 = (f32x4){bflo(pp_.x), bfhi(pp_.x), bflo(pp_.y), bfhi(pp_.y)} * s0, y1 = (f32x4){bflo(pp_.z), bfhi(pp_.z), bflo(pp_.w), bfhi(pp_.w)} * s1;
            *(u32x4*)up = pack8(y0, y1);
        }
        __syncthreads();
    }
}

constexpr int NWAVES = 8;
#ifndef PROBE_DELAY
#define PROBE_DELAY -1
#endif
constexpr int RING_BYTES = 131072;
constexpr int GCONST_OFF = RING_BYTES;
constexpr int LDSCTL_OFF = 147456 - 1024, MISC_OFF = LDSCTL_OFF + 320;
constexpr int LDS_BYTES = 147456;

struct Args {
    const float* x; const float* norm_g; const float* w_in; const float* a_ws; const float* a_bs; const float* a_ln_g; const float* a_ln_b;
    const float* qn; const float* kn; const float* w_oa; const float* w_ob; const float* w_out;
    float* out; unsigned char* ws;
};

constexpr int P0_TP = 68, P0_SCR = 64 * P0_TP * 4, P0_ROWS = M / 4;
constexpr int P0_NWA = (D / 64) * 96, P0_L0 = P0_ROWS + P0_NWA, P0_L1 = (D / 64) * 64, P0_IOA = (D / 64) * (D / 64), P0_IOB = (BW / 64) * (D / 64), P0_L2 = 2 * P0_IOA + P0_IOB;
struct P0Item { const float* src; bf16_t* dst; unsigned char* dst8; int N, ldo, rskip; bool rows, fp8; };
__device__ __forceinline__ P0Item p0_item(int list, int it, const float* x, const float* w_in, const float* w_oa, const float* w_ob, const float* w_out, bf16_t* xn, bf16_t* win, bf16_t* wcat, bf16_t* wout, unsigned char* xn8) {
    P0Item q; q.rows = (list == 0) && it < P0_ROWS; q.N = D; q.ldo = D; q.fp8 = false; q.dst8 = xn8; q.rskip = 0;
    if (q.rows) { q.src = x + (size_t)it * 4 * D; q.dst = xn + (size_t)it * 4 * D; q.dst8 = xn8 + (size_t)it * 4 * D; return q; }
    if (list < 2) {
        const int r = list == 0 ? it - P0_ROWS : it, nt_ = list == 0 ? 96 : 64, kb = r / nt_, j = r % nt_;
        const int nb = list == 0 ? (j < 80 ? 48 + j : 64 + j) : (j < 48 ? j : 80 + j);
        q.N = NIN; q.src = w_in + (size_t)(64 * kb) * NIN + 64 * nb; q.dst = win + (size_t)win_row_of_col(64 * nb) * D + 64 * kb;
        q.rskip = (list == 1 && nb < 48 && (nb < 16 || nb >= 32)) ? 32 : 0;
        q.fp8 = list == 0; q.dst8 = (unsigned char*)win + (size_t)win_row_of_col(64 * nb) * D + (kb >> 1) * 128 + 32 * (kb & 1);
        return q;
    }
    int r = it;
    if (r < P0_IOA) { const int kb = r / (D / 64), nb = r % (D / 64); q.ldo = KCAT; q.src = w_oa + (size_t)(64 * kb) * D + 64 * nb; q.dst = wcat + (size_t)(64 * nb) * KCAT + 64 * kb; return q; } r -= P0_IOA;
    if (r < P0_IOB) { const int kb = r / (D / 64), nb = r % (D / 64); q.ldo = KCAT; q.src = w_ob + (size_t)(64 * kb) * D + 64 * nb; q.dst = wcat + (size_t)(64 * nb) * KCAT + D + 64 * kb; return q; } r -= P0_IOB;
    { const int kb = r / (D / 64), nb = r % (D / 64); q.src = w_out + (size_t)(64 * kb) * D + 64 * nb; q.dst = wout + (size_t)(64 * nb) * D + 64 * kb; return q; }
}
typedef float v16f __attribute__((ext_vector_type(16)));
typedef unsigned v6u __attribute__((ext_vector_type(6)));
__device__ __forceinline__ void mx6_pack(const v16f a, const v16f b, u32x4& o0, u32x4& o1) {
    float am = 0.f;
#pragma unroll
    for (int i = 0; i < 16; ++i) am = fmaxf(am, fmaxf(fabsf(a[i]), fabsf(b[i])));
    const unsigned eb = (__float_as_uint(am) >> 23) & 0xffu, sb = eb > 2u ? eb - 2u : 0u;
    const float mul = __uint_as_float((254u - sb) << 23);
    const v6u r = __builtin_amdgcn_cvt_scalef32_2xpk16_fp6_f32(a * mul, b * mul, 1.0f);
    o0 = (u32x4){r[0], r[1], r[2], r[3]}; o1 = (u32x4){r[4], r[5], sb * 0x01010101u, 0u};
}
__device__ __forceinline__ void p0_load(const P0Item& q, f32x4 (&v)[16], int lane) {
    if (q.rows) {
#pragma unroll
        for (int i = 0; i < 16; ++i) v[i] = __builtin_nontemporal_load((const f32x4*)(q.src + (size_t)(i >> 2) * D) + lane + 64 * (i & 3));
    } else {
#pragma unroll
        for (int i = 0; i < 16; ++i) v[i] = __builtin_nontemporal_load((const f32x4*)(q.src + (size_t)(4 * i + (lane >> 4)) * q.N + 4 * (lane & 15)));
    }
}
__device__ __forceinline__ void p0_process(const P0Item& q, const f32x4 (&v)[16], const float* g, LAS float* scr, int lane) {
    if (q.rows) {
        f32x4 gj[4];
#pragma unroll
        for (int j = 0; j < 4; ++j) gj[j] = ((const f32x4*)g)[lane + 64 * j];
#pragma unroll
        for (int r = 0; r < 4; ++r) {
            const float s = (sumsq4(v[4 * r]) + sumsq4(v[4 * r + 1])) + (sumsq4(v[4 * r + 2]) + sumsq4(v[4 * r + 3]));
            const float rstd = __builtin_amdgcn_rsqf(wave_sum(s) * (1.f / D) + EPS);
            unsigned long long* o8 = (unsigned long long*)(q.dst + (size_t)r * D) + lane;
#pragma unroll
            for (int j = 0; j < 4; ++j) { const f32x4 y = v[4 * r + j] * rstd * gj[j]; o8[64 * j] = (unsigned long long)pk2(y.x, y.y) | ((unsigned long long)pk2(y.z, y.w) << 32);
                LAS float* sp = scr + (r * 32 + 8 * j + (lane >> 3)) * 34 + 4 * (lane & 7);
                *(LAS f32x2*)sp = (f32x2){y.x, y.y}; *(LAS f32x2*)(sp + 2) = (f32x2){y.z, y.w}; }
        }
        LDS_WAIT(); asm volatile("" ::: "memory");
#pragma unroll 1
        for (int t = 0; t < 2; ++t) {
            const int B = lane + 64 * t, r = B >> 5, kb = B & 31; const LAS f32x2* bp = (const LAS f32x2*)(scr + B * 34);
            v16f a, b;
#pragma unroll
            for (int i = 0; i < 8; ++i) { const f32x2 x0 = bp[i], x1 = bp[8 + i]; a[2 * i] = x0.x; a[2 * i + 1] = x0.y; b[2 * i] = x1.x; b[2 * i + 1] = x1.y; }
            u32x4 o0, o1; mx6_pack(a, b, o0, o1);
            unsigned char* dp = q.dst8 + (size_t)r * D + (kb >> 2) * 128 + 16 * (kb & 3);
            *(u32x4*)dp = o0; *(u32x4*)(dp + 64) = o1;
        }
        LDS_WAIT(); asm volatile("" ::: "memory");
    } else {
#pragma unroll
        for (int i = 0; i < 16; ++i) *(LAS f32x4*)(scr + (4 * i + (lane >> 4)) * P0_TP + 4 * (lane & 15)) = v[i];
        LDS_WAIT(); asm volatile("" ::: "memory");
        if (q.fp8) {
#pragma unroll 1
            for (int t = 0; t < 2; ++t) {
                const LAS float* sc_ = scr + (32 * t) * P0_TP + lane;
                v16f a, b;
#pragma unroll
                for (int i = 0; i < 16; ++i) { a[i] = sc_[i * P0_TP]; b[i] = sc_[(16 + i) * P0_TP]; }
                u32x4 o0, o1; mx6_pack(a, b, o0, o1);
                unsigned char* dp = q.dst8 + (size_t)lane * D + 16 * t;
                *(u32x4*)dp = o0; *(u32x4*)(dp + 64) = o1;
            }
            LDS_WAIT(); asm volatile("" ::: "memory");
            return;
        }
        const int c = lane & 7;
#pragma unroll
        for (int j = 0; j < 8; ++j) { const int n = (lane >> 3) + 8 * j; const LAS float* s = scr + (8 * c) * P0_TP + n;
            v4u o; o.x = pk2(s[0 * P0_TP], s[1 * P0_TP]); o.y = pk2(s[2 * P0_TP], s[3 * P0_TP]); o.z = pk2(s[4 * P0_TP], s[5 * P0_TP]); o.w = pk2(s[6 * P0_TP], s[7 * P0_TP]);
            *(GAS v4u*)(q.dst + (size_t)(n + q.rskip * (n >> 5)) * q.ldo + 8 * c) = o; }
        LDS_WAIT(); asm volatile("" ::: "memory");
    }
}

__global__ void __launch_bounds__(NWAVES * 64, 2) fwd_megakernel(Args a) {
    extern __shared__ __attribute__((aligned(16))) unsigned char lds_raw[];
    LAS unsigned char* lds = (LAS unsigned char*)lds_raw;
    volatile LAS unsigned* MISC = (volatile LAS unsigned*)(lds + MISC_OFF);
    const int tid = threadIdx.x, lane = tid & 63, wave = __builtin_amdgcn_readfirstlane(tid >> 6);
    const int G = gridDim.x, bx = blockIdx.x, vcu = (G % 8 == 0) ? (bx % 8) * (G / 8) + bx / 8 : bx;
    unsigned char* ws = a.ws;
    gu32* ctl = (gu32*)(ws + WS_CTL); float* ctlf = (float*)(ws + WS_CTL);
    bf16_t* win = (bf16_t*)(ws + WS_WIN); bf16_t* wcat = (bf16_t*)(ws + WS_WCAT); bf16_t* wout = (bf16_t*)(ws + WS_WOUT);
    bf16_t* aws = (bf16_t*)(ws + WS_AWS); float* den = (float*)(ws + WS_DEN); float* stats = (float*)(ws + WS_STATS);
    bf16_t* xn = (bf16_t*)(ws + WS_XN); bf16_t* R = (bf16_t*)(ws + WS_R); unsigned char* xn8 = ws + WS_XN8;
    for (int u = tid; u < (LDS_BYTES - LDSCTL_OFF) / 4; u += NWAVES * 64) ((LAS unsigned*)(lds + LDSCTL_OFF))[u] = 0u;
    __syncthreads();
    XcdBarrier bar = xcd_barrier_post((unsigned*)ctl + CW_BAR, MISC + 8);
    const bool cl = (G == 256); const int pmc = 8 * (bx & 7) + ((bx >> 3) & 7), rc = bx >> 6;
    if (tid == 0) __hip_atomic_store((unsigned*)ctl + 3072 + bx, xb_xcc_id() + 1u, __ATOMIC_RELAXED, __HIP_MEMORY_SCOPE_AGENT);
#define SEAM_CL(k, n) do { xcd_barrier_arrive(); if (cl) cl_barrier_wait((unsigned*)ctl, bar.bar, pmc, 4u * (n)); else xcd_barrier_wait(bar); \
        if (PROBE_DELAY == (k)) { const unsigned long long t1_ = rt(); while (rt() < t1_ + (t1_ - tph_)) __builtin_amdgcn_s_sleep(8); } if (PROBE_DELAY >= 0) tph_ = rt(); } while (0)
    const int gw = vcu * NWAVES + wave, NGW = G * NWAVES;
    unsigned long long tph_ = (PROBE_DELAY >= 0) ? rt() : 0ull;
#define SEAM(k) do { xcd_barrier(bar); if (PROBE_DELAY == (k)) { const unsigned long long t1_ = rt(); while (rt() < t1_ + (t1_ - tph_)) __builtin_amdgcn_s_sleep(8); } \
        if (PROBE_DELAY >= 0) tph_ = rt(); } while (0)

#define BARRIER_WINDOW(L, n) do { xcd_barrier_arrive(); \
        if (wave != 0) { LAS float* scr_ = (LAS float*)(lds + wave * P0_SCR); f32x4 vw_[16]; int lane_w_ = lane; asm volatile("" : "+v"(lane_w_));     \
            for (int it_ = vcu * 7 + wave - 1; it_ < (n); it_ += G * 7) { const P0Item q_ = p0_item(it_ < P0_L1 ? 1 : 2, it_ < P0_L1 ? it_ : it_ - P0_L1, a.x, a.w_in, a.w_oa, a.w_ob, a.w_out, xn, win, wcat, wout, xn8); p0_load(q_, vw_, lane_w_); p0_process(q_, vw_, a.norm_g, scr_, lane_w_); } } \
        xcd_barrier_wait(bar); } while (0)
#define SEAM_W(k, L, n) do { BARRIER_WINDOW(L, n); if (PROBE_DELAY == (k)) { const unsigned long long t1_ = rt(); while (rt() < t1_ + (t1_ - tph_)) __builtin_amdgcn_s_sleep(8); } \
        if (PROBE_DELAY >= 0) tph_ = rt(); } while (0)
    {
        LAS float* scr = (LAS float*)(lds + wave * P0_SCR);
#define P0_ITEM(i) p0_item(0, (i), a.x, a.w_in, a.w_oa, a.w_ob, a.w_out, xn, win, wcat, wout, xn8)
        f32x4 va[16], vb[16];
        P0Item qa = P0_ITEM(0), qb = qa;
        for (int it = gw; it < P0_NWA; it += NGW) { qa = P0_ITEM(P0_ROWS + it); p0_load(qa, va, lane); p0_process(qa, va, a.norm_g, scr, lane); }
        xcd_barrier_arrive(); xcd_barrier_signal(bar);
        const int rbase = pmc * 64 + rc * 16 + wave * 2;
        for (int k = 0; ; k += 2) {
            const int r0 = cl ? rbase + k : gw + k * NGW, r1 = cl ? r0 + 1 : r0 + NGW;
            const bool h0 = cl ? k < 2 : r0 < P0_ROWS, h1 = cl ? k < 2 : r1 < P0_ROWS;
            if (!h0) break;
            qa = P0_ITEM(r0); p0_load(qa, va, lane);
            if (h1) { qb = P0_ITEM(r1); p0_load(qb, vb, lane); }
            p0_process(qa, va, a.norm_g, scr, lane);
            if (h1) p0_process(qb, vb, a.norm_g, scr, lane);
        }
#undef P0_ITEM
        for (int idx = vcu * 512 + tid; idx < AG * CH * CH; idx += G * 512) { const int i = (idx / CH) % CH, j = idx % CH; aws[idx] = (bf16_t)f2bf(j <= i ? a.a_ws[idx] : 0.f); }
        if (bx == 0 && wave == 0) {
            float c = 0.f;
            for (int p = 0; p < 3; ++p) { const float mq = wave_max(fabsf(a.qn[p * 64 + lane])), mk = wave_max(fabsf(a.kn[p * 64 + lane])); c = fmaxf(c, mq * mk); }
            if (lane == 0) ctlf[CONST_OFF] = c * 64.f * QSCALE * 1.001f;
        }
    }
    xcd_barrier_arrive(); xcd_barrier_finish(bar);
    if (cl) cl_barrier_wait((unsigned*)ctl, bar.bar, pmc, 4u, 2); else xcd_barrier_wait(bar);
    if (PROBE_DELAY == 0) { const unsigned long long t1_ = rt(); while (rt() < t1_ + (t1_ - tph_)) __builtin_amdgcn_s_sleep(8); }
    if (PROBE_DELAY >= 0) tph_ = rt();
    for (int i = tid; i < 384; i += NWAVES * 64) ((LAS float*)(lds + GCONST_OFF))[i] = i < 192 ? a.qn[i] : a.kn[i - 192];
    __syncthreads();

    {
        pg8::Gemm g{(const bf16_t*)xn8, win, D / 2, D / 2, D / 2}; pg8::StaticOrder S; S.init(M, NA, G, bx);
        EpiA E{R, (const LAS float*)(lds + GCONST_OFF)};
        pg8::gemm_phase<EpiA, pg8::StaticOrder, true, true>(lds, g, S, E);
    }
    SEAM_W(1, 1, P0_L1 + P0_L2);

    {
        const float cneg = -ctlf[CONST_OFF];
        attn_phase<false>(vcu, G, 1024, R, den, cneg, lds, tid);
        xcd_barrier_arrive(); xcd_barrier_signal(bar);
        if (PROBE_DELAY >= 0) tph_ = rt();
        const int pq_ = pmc & 3, g4_ = (pmc >> 2) * 4 + rc, g8_ = ((pmc >> 2) * 2 + (pq_ - 1)) * 4 + rc;
        const int f2_ = !cl ? vcu : pq_ == 0 ? g4_ : pq_ == 3 ? 320 + g4_ : 64 + g8_;
        const int s2_ = !cl ? G : pq_ == 0 ? 512 : pq_ == 3 ? 64 : 128;
        const int n2_ = !cl ? 512 : (pq_ == 1 || pq_ == 2) ? 320 : 512;
        attn_phase<true>(f2_, s2_, n2_, R, den, cneg, lds, tid, bar.bar + XB_TOPGEN, MISC + 8);
    }
    xcd_barrier_arrive(); xcd_barrier_signal(bar);
    if (PROBE_DELAY >= 0) tph_ = rt();

    {
        pg8::Gemm g{xn, win + (size_t)NA * D, D, D, D}; pg8::StaticOrder S; S.init(M, NB, G, bx);
        EpiB E{R, stats, bar.bar + XB_TOPGEN, MISC + 8};
        pg8::gemm_phase<EpiB, pg8::StaticOrder, true, true>(lds, g, S, E);
    }
    SEAM_CL(4, 1);

    for (int k = 0; k < ((M / CH) * AG + G - 1) / G; ++k) { const int item = cl ? (2 * pmc + k) * AG + rc : vcu + k * G; if (item < (M / CH) * AG) sgu_unit(item, R, stats, aws, a.a_bs, a.a_ln_g, a.a_ln_b, lds, tid); }
    if (cl) { xcd_barrier_arrive(); cl_barrier_signal((unsigned*)ctl, pmc); if (PROBE_DELAY >= 0) tph_ = rt(); } else SEAM(5);

    {
        pg8::Gemm g{R + RC_U, wcat, LDR, KCAT, KCAT}; pg8::SplitOrder S; S.init(M, D, G, bx); if (cl) { S.cw = (unsigned*)ctl + 2048 + 16 * pmc; S.target = 8u; S.armed = true; }
        EpiM E{R};
        pg8::gemm_phase<EpiM, pg8::SplitOrder, true, true>(lds, g, S, E);
    }
    {
        pg8::Gemm g{R + RC_V, wout, LDR, D, D}; pg8::StaticOrder S; S.init(M, D, G, bx);
        EpiOut E{a.x, a.out};
        f32x4 acc[2][2][4][2]; pg8::Unit u0; const bool any = S.next(0, u0);
        xcd_barrier_arrive();
        if (any && wave != 0) E.preload(acc, u0, wave >> 2, wave & 3, lane & 15, lane >> 4);
        if (cl) cl_barrier_wait((unsigned*)ctl, bar.bar, pmc, 12u); else xcd_barrier_wait(bar);
        if (PROBE_DELAY == 6) { const unsigned long long t1_ = rt(); while (rt() < t1_ + (t1_ - tph_)) __builtin_amdgcn_s_sleep(8); }
        if (PROBE_DELAY >= 0) tph_ = rt();
        if (any && wave == 0) E.preload(acc, u0, wave >> 2, wave & 3, lane & 15, lane >> 4);
        pg8::gemm_phase_impl<EpiOut, pg8::StaticOrder, true, true, true>(lds, g, S, E, acc);
    }
    if (PROBE_DELAY == 7) { const unsigned long long t1_ = rt(); while (rt() < t1_ + (t1_ - tph_)) __builtin_amdgcn_s_sleep(8); }
}

extern "C" void kernel_launch(void* const* d_in, const int* in_sizes, int n_in, void* d_out, int out_size, void* d_ws, size_t ws_size, hipStream_t stream) {
    static int grid = 0;
    if (grid == 0) {
        if (n_in != 12 || in_sizes[0] != M * D || out_size != M * D || ws_size < WS_END) { fprintf(stderr, "kernel_launch: unexpected shapes (n_in %d, in0 %d, out %d, ws %zu); nothing launched\n", n_in, n_in > 0 ? in_sizes[0] : -1, out_size, ws_size); grid = -1; return; }
        int dev = 0, cus = 0, per_cu = 0;
        if (hipGetDevice(&dev) != hipSuccess || hipDeviceGetAttribute(&cus, hipDeviceAttributeMultiprocessorCount, dev) != hipSuccess) { fprintf(stderr, "kernel_launch: device query failed\n"); grid = -1; return; }
        if (hipFuncSetAttribute((const void*)fwd_megakernel, hipFuncAttributeMaxDynamicSharedMemorySize, LDS_BYTES) != hipSuccess) { fprintf(stderr, "kernel_launch: hipFuncSetAttribute failed\n"); grid = -1; return; }
        if (hipOccupancyMaxActiveBlocksPerMultiprocessor(&per_cu, (const void*)fwd_megakernel, NWAVES * 64, LDS_BYTES) != hipSuccess || per_cu < 1)
            fprintf(stderr, "kernel_launch: note: occupancy query reports %d workgroups per CU\n", per_cu);
        (void)hipGetLastError();
        grid = cus;
    }
    if (grid < 0) return;
    if (hipMemsetAsync((char*)d_ws + WS_CTL, 0, 32768, stream) != hipSuccess) { fprintf(stderr, "kernel_launch: hipMemsetAsync failed\n"); return; }
    Args a{};
    a.x = (const float*)d_in[0]; a.norm_g = (const float*)d_in[1]; a.w_in = (const float*)d_in[2]; a.a_ws = (const float*)d_in[3]; a.a_bs = (const float*)d_in[4];
    a.a_ln_g = (const float*)d_in[5]; a.a_ln_b = (const float*)d_in[6]; a.qn = (const float*)d_in[7]; a.kn = (const float*)d_in[8];
    a.w_oa = (const float*)d_in[9]; a.w_ob = (const float*)d_in[10]; a.w_out = (const float*)d_in[11];
    a.out = (float*)d_out; a.ws = (unsigned char*)d_ws;
    hipLaunchKernelGGL(fwd_megakernel, dim3(grid), dim3(NWAVES * 64), LDS_BYTES, stream, a);
    const hipError_t le = hipPeekAtLastError();
    if (le != hipSuccess) fprintf(stderr, "kernel_launch: launch failed: %s\n", hipGetErrorName(le));
}
```
